# Optimizing an MI355X kernel written in HIP

```python
import jax, jax.numpy as jnp
from jax import lax
import numpy as np

D_MODEL = 2048
BATCH = 4
SEQ = 4096
DEPTH = 2

A_HEADS = 8
A_HEAD_DIM = 128
A_ROT_DIM = A_HEAD_DIM // 4
IDX_HEADS = 16
IDX_DIM = 64
IDX_ROT_DIM = IDX_DIM // 4
TOPK_MAX = 256
MLA_HEADS = 8
MLA_NOPE = 128
MLA_ROPE = 64
MLA_V = 128
Q_LORA = 512
KV_LORA = 256
FFN_DIM = -(-8 * D_MODEL // (3 * 256)) * 256
ROPE_THETA = 500000.0
MLA_ROPE_THETA = 10000.0
ALPHA = (2 * DEPTH) ** 0.25
BETA = (8 * DEPTH) ** -0.25
LN_EPS = 1e-5
RMS_EPS = 1e-6
Q_BLOCK = 128
SPARSE_Q_BLOCK = 64
A_WIDTH = A_HEADS * A_HEAD_DIM
IN_SIZES = (A_WIDTH, A_WIDTH, A_WIDTH, IDX_HEADS * IDX_DIM, IDX_HEADS, IDX_DIM, Q_LORA, KV_LORA, MLA_ROPE)
IN_COLS = sum(IN_SIZES)

kernel_name = "hybrid_dsa_mla_deepnorm_block"


def _layer_norm(x, g, b):
    xf = x.astype(jnp.float32)
    mu = jnp.mean(xf, axis=-1, keepdims=True)
    var = jnp.mean(jnp.square(xf - mu), axis=-1, keepdims=True)
    y = (xf - mu) * lax.rsqrt(var + LN_EPS) * g.astype(jnp.float32) + b.astype(jnp.float32)
    return y.astype(x.dtype)


def _rms_norm(x, g):
    xf = x.astype(jnp.float32)
    y = xf * lax.rsqrt(jnp.mean(jnp.square(xf), axis=-1, keepdims=True) + RMS_EPS) * g.astype(jnp.float32)
    return y.astype(x.dtype)


def _rope(x, pos, rot_dim, theta):
    half = rot_dim // 2
    inv_freq = theta ** (-2.0 * jnp.arange(half, dtype=jnp.float32) / rot_dim)
    ang = pos.astype(jnp.float32)[..., None] * inv_freq
    cos = jnp.cos(ang)[:, :, None, :].astype(x.dtype)
    sin = jnp.sin(ang)[:, :, None, :].astype(x.dtype)
    x1, x2 = x[..., :half], x[..., half:rot_dim]
    return jnp.concatenate([x1 * cos - x2 * sin, x2 * cos + x1 * sin, x[..., rot_dim:]], axis=-1)


def _to_blocks(a, blk):
    b, s = a.shape[:2]
    return jnp.moveaxis(a.reshape((b, s // blk, blk) + a.shape[2:]), 1, 0)


def _from_blocks(a):
    n, b, blk = a.shape[:3]
    return jnp.moveaxis(a, 0, 1).reshape((b, n * blk) + a.shape[3:])


def _dsa_attention(q, k, v, q_idx, k_idx, w_idx):
    s_len = q.shape[1]
    topk = min(TOPK_MAX, s_len // 4)
    pos_s = jnp.arange(s_len, dtype=jnp.int32)
    scale = A_HEAD_DIM ** -0.5

    def block(args):
        qb, qib, wib, tb = args
        rel = jax.nn.relu(jnp.einsum('bthd,bsd->bths', qib, k_idx).astype(jnp.float32))
        score = jnp.einsum('bths,bth->bts', rel, wib.astype(jnp.float32))
        causal = tb[:, None] >= pos_s[None, :]
        score = jnp.where(causal[None], score, -jnp.inf)
        _, sel = lax.top_k(score, topk)
        k_sel = jax.vmap(lambda kb, ib: kb[ib])(k, sel)
        v_sel = jax.vmap(lambda vb, ib: vb[ib])(v, sel)
        logits = jnp.einsum('bthd,btkhd->bthk', qb, k_sel).astype(jnp.float32) * scale
        valid = (sel <= tb[None, :, None])[:, :, None, :]
        p = jax.nn.softmax(jnp.where(valid, logits, -jnp.inf), axis=-1)
        return jnp.einsum('bthk,btkhd->bthd', p.astype(v.dtype), v_sel)

    out = lax.map(block, (_to_blocks(q, SPARSE_Q_BLOCK), _to_blocks(q_idx, SPARSE_Q_BLOCK),
                          _to_blocks(w_idx, SPARSE_Q_BLOCK), pos_s.reshape(-1, SPARSE_Q_BLOCK)))
    return _from_blocks(out)


def _causal_attention(q, k, v, scale):
    s_len = q.shape[1]
    pos_s = jnp.arange(s_len, dtype=jnp.int32)

    def block(args):
        qb, tb = args
        logits = jnp.einsum('bthd,bshd->bhts', qb, k).astype(jnp.float32) * scale
        mask = tb[:, None] >= pos_s[None, :]
        p = jax.nn.softmax(jnp.where(mask[None, None], logits, -jnp.inf), axis=-1)
        return jnp.einsum('bhts,bshd->bthd', p.astype(v.dtype), v)

    out = lax.map(block, (_to_blocks(q, Q_BLOCK), pos_s.reshape(-1, Q_BLOCK)))
    return _from_blocks(out)


def _hybrid_mixer(x, positions, w_in, g_cq, g_ckv, w_uq, w_ukv, w_o):
    b, s, _ = x.shape
    proj = jnp.einsum('bsd,de->bse', x, w_in)
    offsets = np.cumsum(IN_SIZES)[:-1].tolist()
    qa, ka, va, qi, wi, ki, cq, ckv, kr = jnp.split(proj, offsets, axis=-1)
    qa = _rope(qa.reshape(b, s, A_HEADS, A_HEAD_DIM), positions, A_ROT_DIM, ROPE_THETA)
    ka = _rope(ka.reshape(b, s, A_HEADS, A_HEAD_DIM), positions, A_ROT_DIM, ROPE_THETA)
    va = va.reshape(b, s, A_HEADS, A_HEAD_DIM)
    qi = _rope(qi.reshape(b, s, IDX_HEADS, IDX_DIM), positions, IDX_ROT_DIM, ROPE_THETA)
    ki = _rope(ki[:, :, None, :], positions, IDX_ROT_DIM, ROPE_THETA)[:, :, 0, :]
    wi = wi * (IDX_HEADS ** -0.5 * IDX_DIM ** -0.5)
    out_a = _dsa_attention(qa, ka, va, qi, ki, wi).reshape(b, s, A_WIDTH)
    q_b = jnp.einsum('bsr,re->bse', _rms_norm(cq, g_cq), w_uq).reshape(b, s, MLA_HEADS, MLA_NOPE + MLA_ROPE)
    q_nope = q_b[..., :MLA_NOPE]
    q_pe = _rope(q_b[..., MLA_NOPE:], positions, MLA_ROPE, MLA_ROPE_THETA)
    kv = jnp.einsum('bsr,re->bse', _rms_norm(ckv, g_ckv), w_ukv).reshape(b, s, MLA_HEADS, MLA_NOPE + MLA_V)
    k_nope, v_b = kv[..., :MLA_NOPE], kv[..., MLA_NOPE:]
    k_pe = _rope(kr[:, :, None, :], positions, MLA_ROPE, MLA_ROPE_THETA)
    k_pe = jnp.broadcast_to(k_pe, (b, s, MLA_HEADS, MLA_ROPE))
    q_mla = jnp.concatenate([q_nope, q_pe], axis=-1)
    k_mla = jnp.concatenate([k_nope, k_pe], axis=-1)
    out_b = _causal_attention(q_mla, k_mla, v_b, (MLA_NOPE + MLA_ROPE) ** -0.5).reshape(b, s, MLA_HEADS * MLA_V)
    return jnp.einsum('bse,ed->bsd', jnp.concatenate([out_a, out_b], axis=-1), w_o)


def _swiglu(x, w_gate, w_up, w_down):
    h = jax.nn.silu(jnp.einsum('bsd,df->bsf', x, w_gate)) * jnp.einsum('bsd,df->bsf', x, w_up)
    return jnp.einsum('bsf,fd->bsd', h, w_down)


def setup_inputs(seed: int = 0) -> dict:
    key = jax.random.key(seed)
    ks = jax.random.split(key, 16)
    f32 = jnp.float32
    nrm = lambda k, shape, scale: jax.random.normal(k, shape, f32) * scale
    mix_width = A_WIDTH + MLA_HEADS * MLA_V
    return {
        "x": jax.random.normal(ks[0], (BATCH, SEQ, D_MODEL), f32),
        "positions": jnp.broadcast_to(jnp.arange(SEQ, dtype=jnp.int32), (BATCH, SEQ)),
        "w_in": nrm(ks[1], (DEPTH, D_MODEL, IN_COLS), D_MODEL ** -0.5),
        "g_cq": 1.0 + nrm(ks[2], (DEPTH, Q_LORA), 0.02),
        "g_ckv": 1.0 + nrm(ks[3], (DEPTH, KV_LORA), 0.02),
        "w_uq": nrm(ks[4], (DEPTH, Q_LORA, MLA_HEADS * (MLA_NOPE + MLA_ROPE)), Q_LORA ** -0.5),
        "w_ukv": nrm(ks[5], (DEPTH, KV_LORA, MLA_HEADS * (MLA_NOPE + MLA_V)), KV_LORA ** -0.5),
        "w_o": nrm(ks[6], (DEPTH, mix_width, D_MODEL), BETA * mix_width ** -0.5),
        "ln1_g": 1.0 + nrm(ks[7], (DEPTH, D_MODEL), 0.02),
        "ln1_b": nrm(ks[8], (DEPTH, D_MODEL), 0.02),
        "w_gate": nrm(ks[9], (DEPTH, D_MODEL, FFN_DIM), D_MODEL ** -0.5),
        "w_up": nrm(ks[10], (DEPTH, D_MODEL, FFN_DIM), D_MODEL ** -0.5),
        "w_down": nrm(ks[11], (DEPTH, FFN_DIM, D_MODEL), BETA * FFN_DIM ** -0.5),
        "ln2_g": 1.0 + nrm(ks[12], (DEPTH, D_MODEL), 0.02),
        "ln2_b": nrm(ks[13], (DEPTH, D_MODEL), 0.02),
    }


def reference(x, positions, w_in, g_cq, g_ckv, w_uq, w_ukv, w_o, ln1_g, ln1_b,
              w_gate, w_up, w_down, ln2_g, ln2_b):
    for i in range(DEPTH):
        mix = _hybrid_mixer(x, positions, w_in[i], g_cq[i], g_ckv[i], w_uq[i], w_ukv[i], w_o[i])
        x = _layer_norm(ALPHA * x + mix, ln1_g[i], ln1_b[i])
        ffn = _swiglu(x, w_gate[i], w_up[i], w_down[i])
        x = _layer_norm(ALPHA * x + ffn, ln2_g[i], ln2_b[i])
    return x
```

```cpp
#include <hip/hip_runtime.h>
#include <hip/hip_cooperative_groups.h>
#include <cstdio>
namespace cg = cooperative_groups;

constexpr int T_ = 16384, S_ = 4096, NB_ = 4, DM_ = 2048, FF_ = 5632, INC_ = 5008;
constexpr float LOG2E_ = 1.4426950408889634f;
constexpr float QA_SCALE_ = 0.08838834764831845f * LOG2E_;
constexpr float QM_SCALE_ = 0.07216878364870323f * LOG2E_;
constexpr float ALPHA_ = 1.4142135623730951f;
constexpr int RTW_ = 112;

typedef __bf16 bf16x2_t __attribute__((ext_vector_type(2)));
typedef float f32x2_t __attribute__((ext_vector_type(2)));
__device__ __forceinline__ unsigned pk2(float a, float b) { f32x2_t v = {a, b}; bf16x2_t r = __builtin_convertvector(v, bf16x2_t); return __builtin_bit_cast(unsigned, r); }
__device__ __forceinline__ void rot2(float& a, float& b, float c, float s) { const float na = a * c - b * s, nb = b * c + a * s; a = na; b = nb; }

__device__ __forceinline__ int fresh_tid() { int t = (int)threadIdx.x; asm volatile("" : "+v"(t)); return t; }

namespace pg8 {
#define PG8_LAS __attribute__((address_space(3)))
typedef unsigned short bf16_t;
typedef short bf16x8 __attribute__((ext_vector_type(8)));
typedef float f32x4 __attribute__((ext_vector_type(4)));
typedef unsigned u32x4 __attribute__((ext_vector_type(4)));
constexpr int BM = 256, BK = 64, HALF = 128, HTB = HALF * BK * 2  , STAGE_BYTES = 8 * HTB, NXCD = 8, WGM = 8;

__host__ __device__ __forceinline__ int lds_byte(int r, int c) { const int st = (r >> 4) * 2 + (c >> 5), rr = r & 15, cc = c & 31, ob = rr * 64 + cc * 2; return st * 1024 + (ob ^ (((ob >> 9) & 1) << 5)); }
__host__ __device__ __forceinline__ void stage_rc(int b, int& R, int& C) { const int st = b / 1024, sb = b % 1024, swz = sb ^ (((sb >> 9) & 1) << 5); R = (st >> 1) * 16 + swz / 64; C = (st & 1) * 32 + (swz % 64) / 2; }
__host__ __device__ __forceinline__ int perm32(int rho) { const int n = rho >> 4, i = rho & 15; return 8 * (i >> 2) + 4 * n + (i & 3); }

struct Unit { int pm, pn; };
struct Gemm { const bf16_t* A; const bf16_t* Bt; int M, N, K; };

struct StaticOrder {
    int nM, nN, nwg, G, c;
    __host__ __device__ void init(int M, int N, int G_, int c_) { nM = M / BM; nN = N / BM; nwg = nM * nN; G = G_; c = c_; }
    __host__ __device__ bool next(int i, Unit& u) const {
        const long L = (long)i * G + c; if (L >= nwg) return false;
        int wgid = (int)L; { const int q = nwg / NXCD, r = nwg % NXCD, xcd = wgid % NXCD, off = wgid / NXCD; wgid = (xcd < r ? xcd * (q + 1) : r * (q + 1) + (xcd - r) * q) + off; }
        const int nig = WGM * nN, gid = wgid / nig, fm = gid * WGM, gsz = (nM - fm) < WGM ? (nM - fm) : WGM;
        u.pm = fm + ((wgid % nig) % gsz); u.pn = (wgid % nig) / gsz; return true;
    }
    __device__ __forceinline__ void a_ready(const Unit&) const {}
    __device__ __forceinline__ void done(const Unit&) const {}
};
typedef unsigned u32x4_t __attribute__((ext_vector_type(4)));
__device__ __forceinline__ u32x4_t pack8(const f32x4& v0, const f32x4& v1) { u32x4_t w; w.x = pk2(v0[0], v0[1]); w.y = pk2(v0[2], v0[3]); w.z = pk2(v1[0], v1[1]); w.w = pk2(v1[2], v1[3]); return w; }
__device__ __forceinline__ void rope4(f32x4& v0, f32x4& v1, const float* tab) {
    const f32x4 c0 = *(const f32x4*)tab, c1 = *(const f32x4*)(tab + 4);
    const float cs[4] = {c0[0], c0[2], c1[0], c1[2]}, sn[4] = {c0[1], c0[3], c1[1], c1[3]};
#pragma unroll
    for (int j = 0; j < 4; ++j) { const float a = v0[j], b = v1[j]; v0[j] = a * cs[j] - b * sn[j]; v1[j] = b * cs[j] + a * sn[j]; }
}
__device__ __forceinline__ void rope4v(f32x4& v0, f32x4& v1, const f32x4& c0, const f32x4& c1) {
    const float cs[4] = {c0[0], c0[2], c1[0], c1[2]}, sn[4] = {c0[1], c0[3], c1[1], c1[3]};
#pragma unroll
    for (int j = 0; j < 4; ++j) { const float a = v0[j], b = v1[j]; v0[j] = a * cs[j] - b * sn[j]; v1[j] = b * cs[j] + a * sn[j]; }
}
__device__ __forceinline__ float sumsq8(const f32x4& a, const f32x4& b) { return a[0]*a[0] + a[1]*a[1] + a[2]*a[2] + a[3]*a[3] + b[0]*b[0] + b[1]*b[1] + b[2]*b[2] + b[3]*b[3]; }

struct EpiInMain {
    static constexpr int ID = 1; static constexpr bool PERM = true, AFTER_DRAIN = false;
    bf16_t *qa, *ka, *qi, *cq, *ckv, *ki, *kr; float *wi, *rsq, *rskv; const float* rt;
    __device__ __forceinline__ void operator()(const f32x4 (&acc)[2][2][4][2], const Unit& u, int wr, int wc, int fr, int fq) const {
        const int row0 = u.pm * BM + wr * 64 + fr, pn = u.pn, cw = wc * 32 + 8 * fq;
        if (pn < 8) {
            bf16_t* O = pn < 4 ? qa : ka; const int colt = (pn & 3) * 256; const float sc = pn < 4 ? QA_SCALE_ : 1.0f;
#pragma unroll
            for (int ai = 0; ai < 2; ++ai) {
                f32x4 tb[4][2];
                if (wc == 0) {
#pragma unroll
                    for (int m = 0; m < 4; ++m) { const float* tp_ = rt + (size_t)(row0 + ai * HALF + m * 16) * RTW_ + 8 * fq; tb[m][0] = *(const f32x4*)tp_; tb[m][1] = *(const f32x4*)(tp_ + 4); } }
#pragma unroll
                for (int m = 0; m < 4; ++m) { const int row = row0 + ai * HALF + m * 16;
#pragma unroll
                    for (int bj = 0; bj < 2; ++bj) { f32x4 v0 = acc[ai][bj][m][0], v1 = acc[ai][bj][m][1];
                        if (wc == 0) rope4v(v0, v1, tb[m][0], tb[m][1]);
                        v0 *= sc; v1 *= sc;
                        *(u32x4_t*)(O + (size_t)row * 1024 + colt + bj * HALF + cw) = pack8(v0, v1); } } }
        } else if (pn < 12) {
            const int colt = (pn - 8) * 256; const bool rp = ((wc & 1) == 0) && (fq < 2);
#pragma unroll
            for (int ai = 0; ai < 2; ++ai) {
                f32x4 tb[4][2];
                if ((wc & 1) == 0) {
#pragma unroll
                    for (int m = 0; m < 4; ++m) { const float* tp_ = rt + (size_t)(row0 + ai * HALF + m * 16) * RTW_ + 96 + 8 * (fq & 1); tb[m][0] = *(const f32x4*)tp_; tb[m][1] = *(const f32x4*)(tp_ + 4); } }
#pragma unroll
                for (int m = 0; m < 4; ++m) { const int row = row0 + ai * HALF + m * 16;
#pragma unroll
                    for (int bj = 0; bj < 2; ++bj) { f32x4 v0 = acc[ai][bj][m][0], v1 = acc[ai][bj][m][1];
                        if (rp) rope4v(v0, v1, tb[m][0], tb[m][1]);
                        *(u32x4_t*)(qi + (size_t)row * 1024 + colt + bj * HALF + cw) = pack8(v0, v1); } } }
        } else if (pn < 15) {
            const bool isq = pn < 14; bf16_t* O = isq ? cq : ckv; const int ldo = isq ? 512 : 256, colt = isq ? (pn - 12) * 256 : 0;
#pragma unroll
            for (int ai = 0; ai < 2; ++ai)
#pragma unroll
                for (int m = 0; m < 4; ++m) { const int row = row0 + ai * HALF + m * 16; float ss = 0.f;
#pragma unroll
                    for (int bj = 0; bj < 2; ++bj) { const f32x4 v0 = acc[ai][bj][m][0], v1 = acc[ai][bj][m][1]; ss += sumsq8(v0, v1);
                        *(u32x4_t*)(O + (size_t)row * ldo + colt + bj * HALF + cw) = pack8(v0, v1); }
                    ss += __shfl_xor(ss, 16); ss += __shfl_xor(ss, 32);
                    if (fq == 0) { if (isq) rsq[(size_t)row * 8 + (pn - 12) * 4 + wc] = ss; else rskv[(size_t)row * 4 + wc] = ss; } }
        } else {
#pragma unroll
            for (int ai = 0; ai < 2; ++ai)
#pragma unroll
                for (int m = 0; m < 4; ++m) { const int row = row0 + ai * HALF + m * 16;
                    f32x4 v0 = acc[ai][0][m][0], v1 = acc[ai][0][m][1];
                    if (wc < 2) { if (wc == 0 && fq < 2) rope4(v0, v1, rt + (size_t)row * RTW_ + 96 + 8 * fq);
                        *(u32x4_t*)(ki + (size_t)row * 64 + cw) = pack8(v0, v1);
                    } else { const int p0 = cw - 64;
                        rope4(v0, v1, rt + (size_t)row * RTW_ + 32 + p0);
                        *(u32x4_t*)(kr + (size_t)row * 64 + p0) = pack8(v0, v1); }
                    if (wc == 0 && fq < 2) { const f32x4 w0 = acc[ai][1][m][0] * 0.03125f, w1 = acc[ai][1][m][1] * 0.03125f;
                        *(f32x4*)(wi + (size_t)row * 16 + 8 * fq) = w0; *(f32x4*)(wi + (size_t)row * 16 + 8 * fq + 4) = w1; } }
        }
    }
};
struct EpiPlainBf16 {
    static constexpr int ID = 2; static constexpr bool PERM = true, AFTER_DRAIN = false;
    bf16_t* O; int ldc;
    __device__ __forceinline__ void operator()(const f32x4 (&acc)[2][2][4][2], const Unit& u, int wr, int wc, int fr, int fq) const {
        const int row0 = u.pm * BM + wr * 64 + fr, col0 = u.pn * BM + wc * 32 + 8 * fq;
#pragma unroll
        for (int ai = 0; ai < 2; ++ai)
#pragma unroll
            for (int m = 0; m < 4; ++m) { bf16_t* rowp = O + (size_t)(row0 + ai * HALF + m * 16) * ldc + col0;
#pragma unroll
                for (int bj = 0; bj < 2; ++bj) *(u32x4_t*)(rowp + bj * HALF) = pack8(acc[ai][bj][m][0], acc[ai][bj][m][1]); }
    }
};
struct EpiUq {
    static constexpr int ID = 4; static constexpr bool PERM = true, AFTER_DRAIN = false;
    bf16_t* O; const float* rsq; const float* rt;
    __device__ __forceinline__ void operator()(const f32x4 (&acc)[2][2][4][2], const Unit& u, int wr, int wc, int fr, int fq) const {
        const int row0 = u.pm * BM + wr * 64 + fr;
#pragma unroll
        for (int ai = 0; ai < 2; ++ai) {
            f32x4 pq[4][2];
#pragma unroll
            for (int m = 0; m < 4; ++m) { const float* rp_ = rsq + (size_t)(row0 + ai * HALF + m * 16) * 8; pq[m][0] = *(const f32x4*)rp_; pq[m][1] = *(const f32x4*)(rp_ + 4); }
#pragma unroll
            for (int m = 0; m < 4; ++m) { const int row = row0 + ai * HALF + m * 16;
                const f32x4 p0 = pq[m][0], p1 = pq[m][1];
                const float ssum = ((p0[0] + p0[1]) + (p0[2] + p0[3])) + ((p1[0] + p1[1]) + (p1[2] + p1[3]));
                const float sc = __builtin_amdgcn_rsqf(ssum * (1.0f / 512.0f) + 1e-6f) * QM_SCALE_;
#pragma unroll
                for (int bj = 0; bj < 2; ++bj) { const int c = u.pn * BM + bj * HALF + wc * 32 + 8 * fq; const int within = c % 192;
                    f32x4 v0 = acc[ai][bj][m][0], v1 = acc[ai][bj][m][1];
                    if (within >= 128) rope4(v0, v1, rt + (size_t)row * RTW_ + 32 + (within - 128));
                    v0 *= sc; v1 *= sc;
                    *(u32x4_t*)(O + (size_t)row * 1536 + c) = pack8(v0, v1); } } }
    }
};
struct EpiUkvK {
    static constexpr int ID = 8; static constexpr bool PERM = true, AFTER_DRAIN = false;
    bf16_t* O; const float* rskv;
    __device__ __forceinline__ void operator()(const f32x4 (&acc)[2][2][4][2], const Unit& u, int wr, int wc, int fr, int fq) const {
        const int row0 = u.pm * BM + wr * 64 + fr, col0 = u.pn * BM + wc * 32 + 8 * fq;
#pragma unroll
        for (int ai = 0; ai < 2; ++ai) {
            f32x4 pk[4];
#pragma unroll
            for (int m = 0; m < 4; ++m) pk[m] = *(const f32x4*)(rskv + (size_t)(row0 + ai * HALF + m * 16) * 4);
#pragma unroll
            for (int m = 0; m < 4; ++m) { const int row = row0 + ai * HALF + m * 16;
                const f32x4 p0 = pk[m];
                const float sc = __builtin_amdgcn_rsqf(((p0[0] + p0[1]) + (p0[2] + p0[3])) * (1.0f / 256.0f) + 1e-6f);
#pragma unroll
                for (int bj = 0; bj < 2; ++bj) { f32x4 v0 = acc[ai][bj][m][0] * sc, v1 = acc[ai][bj][m][1] * sc;
                    *(u32x4_t*)(O + (size_t)row * 1024 + col0 + bj * HALF) = pack8(v0, v1); } } }
    }
};
struct EpiUkvV {
    static constexpr int ID = 16; static constexpr bool PERM = true, AFTER_DRAIN = false;
    bf16_t* O; const float* rskv;
    __device__ __forceinline__ void operator()(const f32x4 (&acc)[2][2][4][2], const Unit& u, int wr, int wc, int fr, int fq) const {
        const int row0 = u.pm * BM + wr * 64 + fr, col0 = u.pn * BM + wc * 32 + 8 * fq;
#pragma unroll
        for (int bj = 0; bj < 2; ++bj) { const int c = col0 + bj * HALF; f32x4 s0, s1;
#pragma unroll
            for (int j = 0; j < 4; ++j) { const f32x4 a = *(const f32x4*)(rskv + (size_t)(c + j) * 4), b = *(const f32x4*)(rskv + (size_t)(c + 4 + j) * 4);
                s0[j] = __builtin_amdgcn_rsqf(((a[0] + a[1]) + (a[2] + a[3])) * (1.0f / 256.0f) + 1e-6f);
                s1[j] = __builtin_amdgcn_rsqf(((b[0] + b[1]) + (b[2] + b[3])) * (1.0f / 256.0f) + 1e-6f); }
#pragma unroll
            for (int ai = 0; ai < 2; ++ai)
#pragma unroll
                for (int m = 0; m < 4; ++m) { const f32x4 v0 = acc[ai][bj][m][0] * s0, v1 = acc[ai][bj][m][1] * s1;
                    *(u32x4_t*)(O + (size_t)(row0 + ai * HALF + m * 16) * T_ + c) = pack8(v0, v1); } }
    }
};
__device__ __forceinline__ f32x4 bf16lo4(unsigned a, unsigned b) { f32x4 r; r[0] = __uint_as_float(a << 16); r[1] = __uint_as_float(a & 0xffff0000u); r[2] = __uint_as_float(b << 16); r[3] = __uint_as_float(b & 0xffff0000u); return r; }
struct EpiResB {
    static constexpr int ID = 32; static constexpr bool PERM = true, AFTER_DRAIN = false;
    bf16_t* Y; const bf16_t* X;
    __device__ __forceinline__ void operator()(const f32x4 (&acc)[2][2][4][2], const Unit& u, int wr, int wc, int fr, int fq) const {
        const int row0 = u.pm * BM + wr * 64 + fr, col0 = u.pn * BM + wc * 32 + 8 * fq;
        u32x4_t xw[2][4][2];
#pragma unroll
        for (int ai = 0; ai < 2; ++ai)
#pragma unroll
            for (int m = 0; m < 4; ++m)
#pragma unroll
                for (int bj = 0; bj < 2; ++bj) xw[ai][m][bj] = *(const u32x4_t*)(X + (size_t)(row0 + ai * HALF + m * 16) * DM_ + col0 + bj * HALF);
#pragma unroll
        for (int ai = 0; ai < 2; ++ai)
#pragma unroll
            for (int m = 0; m < 4; ++m) { const size_t ro = (size_t)(row0 + ai * HALF + m * 16) * DM_ + col0;
#pragma unroll
                for (int bj = 0; bj < 2; ++bj) { const u32x4_t x4 = xw[ai][m][bj];
                    const f32x4 v0 = bf16lo4(x4.x, x4.y) * ALPHA_ + acc[ai][bj][m][0], v1 = bf16lo4(x4.z, x4.w) * ALPHA_ + acc[ai][bj][m][1];
                    *(u32x4_t*)(Y + ro + bj * HALF) = pack8(v0, v1); } }
    }
};
struct EpiGU {
    static constexpr int ID = 64; static constexpr bool PERM = true, AFTER_DRAIN = false;
    bf16_t* O;
    __device__ __forceinline__ void operator()(const f32x4 (&acc)[2][2][4][2], const Unit& u, int wr, int wc, int fr, int fq) const {
        const int row0 = u.pm * BM + wr * 64 + fr, col0 = u.pn * HALF + wc * 32 + 8 * fq;
#pragma unroll
        for (int ai = 0; ai < 2; ++ai)
#pragma unroll
            for (int m = 0; m < 4; ++m) { f32x4 h0, h1;
#pragma unroll
                for (int j = 0; j < 4; ++j) { const float g0 = acc[ai][0][m][0][j], g1 = acc[ai][0][m][1][j];
                    h0[j] = g0 * __builtin_amdgcn_rcpf(1.0f + __builtin_amdgcn_exp2f(-g0 * LOG2E_)) * acc[ai][1][m][0][j];
                    h1[j] = g1 * __builtin_amdgcn_rcpf(1.0f + __builtin_amdgcn_exp2f(-g1 * LOG2E_)) * acc[ai][1][m][1][j]; }
                *(u32x4_t*)(O + (size_t)(row0 + ai * HALF + m * 16) * FF_ + col0) = pack8(h0, h1); }
    }
};


template <class Epi, class Sched, bool ALIGN_EPI = false, bool SP2 = false>
__device__ __forceinline__ void gemm_phase(PG8_LAS unsigned char* lds, const Gemm g, const Sched& S, const Epi& E) {
    const int tid = fresh_tid(), wid = __builtin_amdgcn_readfirstlane(tid >> 6), lane = tid & 63, wr = wid >> 2, wc = wid & 3, fr = lane & 15, fq = lane >> 4;
    const int K = g.K, nt = K / BK;
    unsigned voffA[2], voffB[2];
#pragma unroll
    for (int i = 0; i < 2; ++i) { int R, C; stage_rc(tid * 16 + i * 8192, R, C); const int Rb = Epi::PERM ? ((R & ~31) + perm32(R & 31)) : R;
        voffA[i] = (unsigned)(R * K + C) * 2u; voffB[i] = (unsigned)(Rb * K + C) * 2u; }
    const size_t kstep = (size_t)(BK * 2);
    const size_t hstep = (size_t)HALF * K * 2;
    const size_t tstep = 2 * hstep;
    const unsigned ldsw = (unsigned)wid * 1024u;
    const int aoff = lds_byte(wr * 64 + fr, fq * 8), boff = lds_byte(wc * 32 + fr, fq * 8);
#define PG8_SA(b, h) (((b) * 2 + (h)) * HTB)
#define PG8_SB(b, h) ((4 + (b) * 2 + (h)) * HTB)
#define PG8_STAGE(bufoff, gbase, voff) do { _Pragma("unroll") for (int _i = 0; _i < 2; ++_i) \
        __builtin_amdgcn_global_load_lds((const unsigned*)((const char*)(gbase) + (voff)[_i]), (PG8_LAS unsigned*)(lds + (bufoff) + ldsw + _i * 8192), 16, 0, 0); } while (0)
#define PG8_LDA(dst, b, h) do { _Pragma("unroll") for (int m = 0; m < 4; ++m) _Pragma("unroll") for (int k = 0; k < 2; ++k) dst[m][k] = *(const PG8_LAS bf16x8*)(lds + PG8_SA(b, h) + aoff + m * 2048 + k * 1024); } while (0)
#define PG8_LDB(dst, b, h) do { _Pragma("unroll") for (int n = 0; n < 2; ++n) _Pragma("unroll") for (int k = 0; k < 2; ++k) dst[n][k] = *(const PG8_LAS bf16x8*)(lds + PG8_SB(b, h) + boff + n * 2048 + k * 1024); } while (0)
#define PG8_MMA(ai, bj, At, Bt) do { __builtin_amdgcn_s_setprio(1); _Pragma("unroll") for (int m = 0; m < 4; ++m) _Pragma("unroll") for (int n = 0; n < 2; ++n) _Pragma("unroll") for (int k = 0; k < 2; ++k) \
        acc[ai][bj][m][n] = __builtin_amdgcn_mfma_f32_16x16x32_bf16(Bt[n][k], At[m][k], acc[ai][bj][m][n], 0, 0, 0); __builtin_amdgcn_s_setprio(0); } while (0)
#define PG8_WAIT_V(n) asm volatile("s_waitcnt vmcnt(" #n ")" ::: "memory")
#define PG8_WAIT_L(n) asm volatile("s_waitcnt lgkmcnt(" #n ")" ::: "memory")
#define PG8_BAR __builtin_amdgcn_s_barrier()
#define PG8_SCHED __builtin_amdgcn_sched_barrier(0)
    Unit cur, nxt; int ui = 0;
    if (!S.next(0, cur)) return;
    f32x4 acc[2][2][4][2];
#pragma unroll
    for (int a = 0; a < 2; ++a)
#pragma unroll
        for (int b = 0; b < 2; ++b)
#pragma unroll
            for (int m = 0; m < 4; ++m)
#pragma unroll
                for (int n = 0; n < 2; ++n) acc[a][b][m][n] = (f32x4){0.f, 0.f, 0.f, 0.f};
    bf16x8 At[4][2], B0[2][2], B1[2][2];
    const char* cA = (const char*)g.A + (size_t)cur.pm * tstep; const char* cB = (const char*)g.Bt + (size_t)cur.pn * tstep;
    S.a_ready(cur);
    if constexpr (SP2) {
        PG8_STAGE(PG8_SB(0, 0), cB, voffB); PG8_STAGE(PG8_SB(0, 1), cB + hstep, voffB); PG8_STAGE(PG8_SA(0, 0), cA, voffA); PG8_STAGE(PG8_SA(0, 1), cA + hstep, voffA);
        if (wr == 1) PG8_BAR;
        PG8_WAIT_V(2); PG8_BAR;
        PG8_STAGE(PG8_SB(1, 0), cB + kstep, voffB); PG8_STAGE(PG8_SA(1, 0), cA + kstep, voffA); PG8_STAGE(PG8_SB(1, 1), cB + hstep + kstep, voffB);
        PG8_WAIT_V(6); PG8_BAR;
    } else {
        PG8_STAGE(PG8_SB(0, 0), cB, voffB); PG8_STAGE(PG8_SA(0, 0), cA, voffA); PG8_STAGE(PG8_SB(0, 1), cB + hstep, voffB); PG8_STAGE(PG8_SA(0, 1), cA + hstep, voffA);
        if (wr == 1) PG8_BAR;
        PG8_WAIT_V(4); PG8_BAR;
        PG8_STAGE(PG8_SB(1, 0), cB + kstep, voffB); PG8_STAGE(PG8_SA(1, 0), cA + kstep, voffA); PG8_STAGE(PG8_SB(1, 1), cB + hstep + kstep, voffB);
        PG8_WAIT_V(6); PG8_BAR;
    }
    for (;;) {
        const bool has_next = S.next(ui + 1, nxt);
        const char* nA = has_next ? (const char*)g.A + (size_t)nxt.pm * tstep : cA; const char* nB = has_next ? (const char*)g.Bt + (size_t)nxt.pn * tstep : cB;
        for (int t = 0; t < nt; t += 2) {
            const bool last = (t == nt - 2);
            const char* a1 = cA + (size_t)(t + 1) * kstep;
            const char* a2 = last ? nA : cA + (size_t)(t + 2) * kstep; const char* b2 = last ? nB : cB + (size_t)(t + 2) * kstep;
            const char* a3 = a2 + kstep; const char* b3 = b2 + kstep;
            if (last && has_next) S.a_ready(nxt);
            if constexpr (SP2) {
            PG8_LDB(B0, 0, 0); PG8_LDB(B1, 0, 1); PG8_SCHED; PG8_LDA(At, 0, 0); PG8_STAGE(PG8_SA(1, 1), a1 + hstep, voffA);
            PG8_WAIT_V(8); PG8_WAIT_L(0); PG8_BAR; PG8_MMA(0, 0, At, B0); PG8_MMA(0, 1, At, B1); PG8_BAR; PG8_SCHED;
            PG8_LDA(At, 0, 1); PG8_STAGE(PG8_SB(0, 0), b2, voffB); PG8_STAGE(PG8_SB(0, 1), b2 + hstep, voffB); PG8_STAGE(PG8_SA(0, 0), a2, voffA);
            PG8_WAIT_V(8); PG8_WAIT_L(0); PG8_BAR; PG8_MMA(1, 0, At, B0); PG8_MMA(1, 1, At, B1); PG8_BAR; PG8_SCHED;
            PG8_LDB(B0, 1, 0); PG8_LDB(B1, 1, 1); PG8_SCHED; PG8_LDA(At, 1, 0); PG8_STAGE(PG8_SA(0, 1), a2 + hstep, voffA);
            PG8_WAIT_V(8); PG8_WAIT_L(0); PG8_BAR; PG8_MMA(0, 0, At, B0); PG8_MMA(0, 1, At, B1); PG8_BAR; PG8_SCHED;
            PG8_LDA(At, 1, 1); PG8_STAGE(PG8_SB(1, 0), b3, voffB); PG8_STAGE(PG8_SB(1, 1), b3 + hstep, voffB); PG8_STAGE(PG8_SA(1, 0), a3, voffA);
            PG8_WAIT_V(8); PG8_WAIT_L(0); PG8_BAR; PG8_MMA(1, 0, At, B0); PG8_MMA(1, 1, At, B1); PG8_BAR; PG8_SCHED;
            } else {
            PG8_LDB(B0, 0, 0); PG8_SCHED; PG8_LDA(At, 0, 0); PG8_STAGE(PG8_SA(1, 1), a1 + hstep, voffA);
            PG8_WAIT_L(8); PG8_BAR; PG8_WAIT_L(0); PG8_MMA(0, 0, At, B0); PG8_BAR; PG8_SCHED;
            PG8_LDB(B1, 0, 1); PG8_STAGE(PG8_SB(0, 0), b2, voffB);
            PG8_BAR; PG8_WAIT_L(0); PG8_MMA(0, 1, At, B1); PG8_BAR;
            PG8_LDA(At, 0, 1); PG8_STAGE(PG8_SA(0, 0), a2, voffA);
            PG8_BAR; PG8_WAIT_L(0); PG8_MMA(1, 0, At, B0); PG8_BAR; PG8_SCHED;
            PG8_STAGE(PG8_SB(0, 1), b2 + hstep, voffB);
            PG8_WAIT_V(6); PG8_BAR; PG8_MMA(1, 1, At, B1); PG8_BAR;
            PG8_LDB(B0, 1, 0); PG8_SCHED; PG8_LDA(At, 1, 0); PG8_STAGE(PG8_SA(0, 1), a2 + hstep, voffA);
            PG8_WAIT_L(8); PG8_BAR; PG8_WAIT_L(0); PG8_MMA(0, 0, At, B0); PG8_BAR; PG8_SCHED;
            PG8_LDB(B1, 1, 1); PG8_STAGE(PG8_SB(1, 0), b3, voffB);
            PG8_BAR; PG8_WAIT_L(0); PG8_MMA(0, 1, At, B1); PG8_BAR;
            PG8_LDA(At, 1, 1); PG8_STAGE(PG8_SA(1, 0), a3, voffA);
            PG8_BAR; PG8_WAIT_L(0); PG8_MMA(1, 0, At, B0); PG8_BAR; PG8_SCHED;
            PG8_STAGE(PG8_SB(1, 1), b3 + hstep, voffB);
            PG8_WAIT_V(6); PG8_BAR; PG8_MMA(1, 1, At, B1); PG8_BAR;
            }
        }
        if constexpr (ALIGN_EPI) { if (wr == 0) PG8_BAR; }
        if constexpr (!Epi::AFTER_DRAIN) { E(acc, cur, wr, wc, fr, fq); S.done(cur); }
        if (!has_next) break;
#pragma unroll
        for (int a = 0; a < 2; ++a)
#pragma unroll
            for (int b = 0; b < 2; ++b)
#pragma unroll
                for (int m = 0; m < 4; ++m)
#pragma unroll
                    for (int n = 0; n < 2; ++n) acc[a][b][m][n] = (f32x4){0.f, 0.f, 0.f, 0.f};
        cur = nxt; cA = nA; cB = nB; ++ui;
        if constexpr (ALIGN_EPI) { if (wr == 1) PG8_BAR; }
    }
    PG8_WAIT_V(0);
    if constexpr (!ALIGN_EPI) { if (wr == 0) PG8_BAR; }
    PG8_BAR;
    if constexpr (Epi::AFTER_DRAIN) { E.fused(acc, cur, wr, wc, fr, fq, lds, wid, lane); S.done(cur); }
#undef PG8_SA
#undef PG8_SB
#undef PG8_STAGE
#undef PG8_LDA
#undef PG8_LDB
#undef PG8_MMA
#undef PG8_WAIT_V
#undef PG8_WAIT_L
#undef PG8_BAR
#undef PG8_SCHED
}
}


using pg8::bf16_t; using pg8::bf16x8; using pg8::f32x4; using pg8::u32x4_t;
typedef float f32x16 __attribute__((ext_vector_type(16)));
typedef short s16x4 __attribute__((ext_vector_type(4)));
#define MFMA32(a, b, c) __builtin_amdgcn_mfma_f32_32x32x16_bf16((a), (b), (c), 0, 0, 0)

constexpr size_t OFF_WIN = 0;
constexpr size_t OFF_WVA = OFF_WIN + 4096ull * 2048 * 2;
constexpr size_t OFF_WUQ = OFF_WVA + 1024ull * 2048 * 2;
constexpr size_t OFF_WUKK = OFF_WUQ + 1536ull * 512 * 2;
constexpr size_t OFF_WUKV = OFF_WUKK + 1024ull * 256 * 2;
constexpr size_t OFF_WO = OFF_WUKV + 1024ull * 256 * 2;
constexpr size_t OFF_RT = OFF_WO + 2048ull * 2048 * 2;
constexpr size_t OFF_MASK = OFF_RT + (size_t)T_ * RTW_ * 4;
constexpr size_t OFF_KNOPE = OFF_MASK + (size_t)T_ * 128 * 4;
constexpr size_t OFF_VTB = OFF_KNOPE + (size_t)T_ * 1024 * 2;
constexpr size_t OFF_WGU = OFF_VTB + (size_t)T_ * 1024 * 2;
constexpr size_t OFF_WDN = OFF_WGU + 11264ull * 2048 * 2;
constexpr size_t OFF_XB = OFF_WDN + 2048ull * 5632 * 2;
constexpr size_t OFF_QA = OFF_XB + (size_t)T_ * 2048 * 2;
constexpr size_t OFF_KA = OFF_QA + (size_t)T_ * 1024 * 2;
constexpr size_t OFF_QI = OFF_KA + (size_t)T_ * 1024 * 2;
constexpr size_t OFF_VTA = OFF_QI + (size_t)T_ * 1024 * 2;
constexpr size_t OFF_CQ = OFF_VTA + (size_t)T_ * 1024 * 2;
constexpr size_t OFF_CKV = OFF_CQ + (size_t)T_ * 512 * 2;
constexpr size_t OFF_KI = OFF_CKV + (size_t)T_ * 256 * 2;
constexpr size_t OFF_KR = OFF_KI + (size_t)T_ * 64 * 2;
constexpr size_t OFF_WI = OFF_KR + (size_t)T_ * 64 * 2;
constexpr size_t OFF_RSQ = OFF_WI + (size_t)T_ * 16 * 4;
constexpr size_t OFF_RSKV = OFF_RSQ + (size_t)T_ * 8 * 4;
constexpr size_t OFF_QM = OFF_RSKV + (size_t)T_ * 4 * 4;
constexpr size_t WS_END = OFF_QM + (size_t)T_ * 1536 * 2;
constexpr size_t OFF_AO = WS_END;
constexpr size_t OFF_BAR = OFF_AO + (size_t)T_ * 2048 * 2;
static_assert(OFF_BAR + 16384 <= 536870912ull, "workspace");
static_assert(WS_END - OFF_QA >= (size_t)T_ * 5632 * 2, "h");

struct Params {
    const float* x; const int* pos; const float *w_in, *g_cq, *g_ckv, *w_uq, *w_ukv, *w_o, *ln1_g, *ln1_b, *w_gate, *w_up, *w_down, *ln2_g, *ln2_b;
    float* out; unsigned char* ws;
};

__device__ __forceinline__ int ropeA(int w) { if (w >= 32) return w; const int g = w >> 3, e = w & 7; return e < 4 ? 4 * g + e : 16 + 4 * g + (e - 4); }
__device__ __forceinline__ int ropeI(int w) { if (w >= 16) return w; const int g = w >> 3, e = w & 7; return e < 4 ? 4 * g + e : 8 + 4 * g + (e - 4); }
__device__ __forceinline__ int ropeM(int p) { const int g = p >> 3, e = p & 7; return e < 4 ? 4 * g + e : 32 + 4 * g + (e - 4); }
struct MapInMain { const float* w; __device__ __forceinline__ const float* operator()(int n) const {
    const int tile = n >> 8, c = n & 255; int src;
    if (tile < 8) { const int col = (tile & 3) * 256 + c, head = col >> 7, wd = col & 127; src = (tile < 4 ? 0 : 1024) + head * 128 + ropeA(wd); }
    else if (tile < 12) { const int col = (tile - 8) * 256 + c, head = col >> 6, wd = col & 63; src = 3072 + head * 64 + ropeI(wd); }
    else if (tile < 14) src = 4176 + (tile - 12) * 256 + c;
    else if (tile == 14) src = 4688 + c;
    else { if (c < 64) src = 4112 + ropeI(c); else if (c < 128) src = 4944 + ropeM(c - 64); else if (c < 144) src = 4096 + (c - 128); else return nullptr; }
    return w + src; } };
struct MapOff { const float* w; __device__ __forceinline__ const float* operator()(int n) const { return w + n; } };
struct MapUq { const float* w; __device__ __forceinline__ const float* operator()(int n) const { const int head = n / 192, wd = n % 192; return w + head * 192 + (wd < 128 ? wd : 128 + ropeM(wd - 128)); } };
struct MapUkv { const float* w; __device__ __forceinline__ const float* operator()(int n) const { return w + (n >> 7) * 256 + (n & 127); } };
struct MapGU { const float *g, *u; __device__ __forceinline__ const float* operator()(int n) const { const int tile = n >> 8, c = n & 255; return c < 128 ? g + tile * 128 + c : u + tile * 128 + (c - 128); } };

template <class Map>
__device__ __forceinline__ void conv_job(unsigned char* lds, const Map map, int ldsrc, int K, int Nd, bf16_t* dst, const float* gain, int& base) {
    const int tid = fresh_tid(), G = gridDim.x; unsigned short* tile = (unsigned short*)lds;
    const int nkt = K / 64, ntiles = (Nd / 64) * nkt, nn = tid & 63, kq = tid >> 6;
    const int first = ((int)blockIdx.x - base % G + G) % G;
    float v[8], vn[8];
#define CONV_LOAD(dst_, i_) do { const int n0_ = ((i_) / nkt) * 64, k0_ = ((i_) % nkt) * 64; const float* cp_ = map(n0_ + nn); \
        _Pragma("unroll") for (int r = 0; r < 8; ++r) { const int kk_ = r * 8 + kq; float x_ = cp_ ? cp_[(size_t)(k0_ + kk_) * ldsrc] : 0.f; if (gain) x_ *= gain[k0_ + kk_]; (dst_)[r] = x_; } } while (0)
    if (first < ntiles) CONV_LOAD(v, first);
    for (int i = first; i < ntiles; i += G) {
        const int n0 = (i / nkt) * 64, k0 = (i % nkt) * 64;
        if (i + G < ntiles) CONV_LOAD(vn, i + G);
#pragma unroll
        for (int r = 0; r < 8; ++r) tile[nn * 66 + r * 8 + kq] = (unsigned short)(pk2(v[r], 0.f) & 0xffffu);
        __syncthreads();
        { const int rn = tid >> 3, pc = tid & 7; const unsigned* s = (const unsigned*)(tile + rn * 66 + pc * 8); uint4 w; w.x = s[0]; w.y = s[1]; w.z = s[2]; w.w = s[3];
          *(uint4*)(dst + (size_t)(n0 + rn) * K + k0 + pc * 8) = w; }
        __syncthreads();
#pragma unroll
        for (int r = 0; r < 8; ++r) v[r] = vn[r];
    }
#undef CONV_LOAD
    base += ntiles;
}
__device__ __forceinline__ void conv_attn_weights(unsigned char* lds, const Params& p, int l) {
    int base = 0; unsigned char* ws = p.ws;
    const float* w_in = p.w_in + (size_t)l * DM_ * INC_;
    conv_job(lds, MapInMain{w_in}, INC_, DM_, 4096, (bf16_t*)(ws + OFF_WIN), nullptr, base);
    conv_job(lds, MapOff{w_in + 2048}, INC_, DM_, 1024, (bf16_t*)(ws + OFF_WVA), nullptr, base);
    conv_job(lds, MapUq{p.w_uq + (size_t)l * 512 * 1536}, 1536, 512, 1536, (bf16_t*)(ws + OFF_WUQ), p.g_cq + l * 512, base);
    conv_job(lds, MapUkv{p.w_ukv + (size_t)l * 256 * 2048}, 2048, 256, 1024, (bf16_t*)(ws + OFF_WUKK), p.g_ckv + l * 256, base);
    conv_job(lds, MapUkv{p.w_ukv + (size_t)l * 256 * 2048 + 128}, 2048, 256, 1024, (bf16_t*)(ws + OFF_WUKV), p.g_ckv + l * 256, base);
    conv_job(lds, MapOff{p.w_o + (size_t)l * 2048 * 2048}, 2048, 2048, 2048, (bf16_t*)(ws + OFF_WO), nullptr, base);
}
__device__ __forceinline__ void conv_ffn_weights(unsigned char* lds, const Params& p, int l) {
    int base = 0; unsigned char* ws = p.ws;
    conv_job(lds, MapGU{p.w_gate + (size_t)l * DM_ * FF_, p.w_up + (size_t)l * DM_ * FF_}, FF_, DM_, 2 * FF_, (bf16_t*)(ws + OFF_WGU), nullptr, base);
    conv_job(lds, MapOff{p.w_down + (size_t)l * FF_ * DM_}, DM_, FF_, DM_, (bf16_t*)(ws + OFF_WDN), nullptr, base);
}
__device__ __forceinline__ void rope_table_job(const int* pos, float* rt) {
    const int tid = fresh_tid();
    for (int idx = blockIdx.x * 512 + tid; idx < T_ * 56; idx += gridDim.x * 512) {
        const int t = idx / 56, f = idx % 56; float theta, e;
        if (f < 16) { theta = 500000.0f; e = (-2.0f * (float)f) / 32.0f; } else if (f < 48) { theta = 10000.0f; e = (-2.0f * (float)(f - 16)) / 64.0f; } else { theta = 500000.0f; e = (-2.0f * (float)(f - 48)) / 16.0f; }
        const float inv = powf(theta, e), ang = (float)pos[t] * inv; float s, c; sincosf(ang, &s, &c);
        rt[(size_t)t * RTW_ + 2 * f] = c; rt[(size_t)t * RTW_ + 2 * f + 1] = s; }
}
__device__ __forceinline__ void x_to_bf16_job(const float* x, bf16_t* xb) {
    const int tid = fresh_tid();
    const size_t n = (size_t)T_ * DM_ / 8, step = (size_t)gridDim.x * 512;
    size_t i = (size_t)blockIdx.x * 512 + tid;
    for (; i + 3 * step < n; i += 4 * step) {
        f32x4 a[4], b[4];
#pragma unroll
        for (int u = 0; u < 4; ++u) { a[u] = *(const f32x4*)(x + (i + u * step) * 8); b[u] = *(const f32x4*)(x + (i + u * step) * 8 + 4); }
#pragma unroll
        for (int u = 0; u < 4; ++u) *(u32x4_t*)(xb + (i + u * step) * 8) = pg8::pack8(a[u], b[u]);
    }
    for (; i < n; i += step) { const f32x4 a = *(const f32x4*)(x + i * 8), b = *(const f32x4*)(x + i * 8 + 4); *(u32x4_t*)(xb + i * 8) = pg8::pack8(a, b); }
}
__device__ __forceinline__ float wave_sum(float v) {
#pragma unroll
    for (int o = 32; o >= 1; o >>= 1) v += __shfl_xor(v, o);
    return v; }
__device__ __forceinline__ void ln_job(const bf16_t* y, const float* g, const float* bta, bf16_t* xb, float* outf) {
    const int tid = fresh_tid(), wv = tid >> 6, lane = tid & 63, step = gridDim.x * 8;
    int row = blockIdx.x * 8 + wv;
    u32x4_t w[4], wn[4];
#pragma unroll
    for (int i = 0; i < 4; ++i) { w[i] = (u32x4_t){0u, 0u, 0u, 0u}; wn[i] = w[i]; }
    if (row < T_) {
#pragma unroll
        for (int i = 0; i < 4; ++i) w[i] = *(const u32x4_t*)(y + (size_t)row * DM_ + 8 * lane + 512 * i); }
    for (; row < T_; row += step) {
        if (row + step < T_) {
#pragma unroll
            for (int i = 0; i < 4; ++i) wn[i] = *(const u32x4_t*)(y + (size_t)(row + step) * DM_ + 8 * lane + 512 * i); }
        f32x4 v[8]; float s = 0.f;
#pragma unroll
        for (int i = 0; i < 4; ++i) { v[2 * i] = pg8::bf16lo4(w[i].x, w[i].y); v[2 * i + 1] = pg8::bf16lo4(w[i].z, w[i].w); }
#pragma unroll
        for (int i = 0; i < 8; ++i) s += (v[i][0] + v[i][1]) + (v[i][2] + v[i][3]);
        const float mu = wave_sum(s) * (1.0f / DM_); float q = 0.f;
#pragma unroll
        for (int i = 0; i < 8; ++i) { v[i] -= mu; q += (v[i][0] * v[i][0] + v[i][1] * v[i][1]) + (v[i][2] * v[i][2] + v[i][3] * v[i][3]); }
        const float rstd = 1.0f / sqrtf(wave_sum(q) * (1.0f / DM_) + 1e-5f);
#pragma unroll
        for (int i = 0; i < 4; ++i) { const int c = 8 * lane + 512 * i;
            const f32x4 o0 = v[2 * i] * rstd * *(const f32x4*)(g + c) + *(const f32x4*)(bta + c), o1 = v[2 * i + 1] * rstd * *(const f32x4*)(g + c + 4) + *(const f32x4*)(bta + c + 4);
            if (xb) *(u32x4_t*)(xb + (size_t)row * DM_ + c) = pg8::pack8(o0, o1);
            if (outf) { *(f32x4*)(outf + (size_t)row * DM_ + c) = o0; *(f32x4*)(outf + (size_t)row * DM_ + c + 4) = o1; } }
#pragma unroll
        for (int i = 0; i < 4; ++i) w[i] = wn[i];
    }
}
__device__ __forceinline__ unsigned f2key(float f) { const unsigned u = __float_as_uint(f); return (u & 0x80000000u) ? ~u : (u | 0x80000000u); }
template <int NR>
__device__ __forceinline__ unsigned long long topk_row(const float* sc, int q, int lane) {
    unsigned key[NR];
#pragma unroll
    for (int r = 0; r < NR; ++r) { const int pp = 64 * r + lane; const float f = __hip_atomic_load(sc + pp, __ATOMIC_RELAXED, __HIP_MEMORY_SCOPE_AGENT); key[r] = (pp <= q) ? f2key(f) : 0u; }
    unsigned lo = 0u, hi = 0xFFFFFFFFu;
    while (hi - lo > 1u) {
        const unsigned mid = lo + ((hi - lo) >> 1); int c = 0;
#pragma unroll
        for (int r = 0; r < NR; ++r) c += __popcll(__ballot(key[r] > mid));
        if (c > 256) lo = mid; else { hi = mid; if (c == 256) break; }
    }
    unsigned long long mine = 0ull;
#pragma unroll
    for (int r = 0; r < NR; ++r) { const unsigned long long bl = __ballot(key[r] > hi); if (lane == r) mine = bl; }
    return mine;
}
typedef float f32x4v __attribute__((ext_vector_type(4)));
#define MFMA16(a, b, c) __builtin_amdgcn_mfma_f32_16x16x32_bf16((a), (b), (c), 0, 0, 0)
__device__ __forceinline__ float relu1(float x) { const int i = __float_as_int(x); return __int_as_float(i > 0 ? i : 0); }
__device__ __forceinline__ float key2f(unsigned k) { return __uint_as_float((k & 0x80000000u) ? (k & 0x7fffffffu) : ~k); }
__device__ __forceinline__ float zscore_of_count(float c, float rn) {
    const float p = c * rn, q = fmaxf(p > 0.5f ? 1.0f - p : p, 1e-7f);
    const float tt = sqrtf(-1.3862943611f * __builtin_amdgcn_logf(q));
    const float zz = tt - (2.30753f + 0.27061f * tt) * __builtin_amdgcn_rcpf(1.0f + tt * (0.99229f + 0.04481f * tt));
    return p > 0.5f ? -zz : zz; }
__device__ __forceinline__ void indexer_job(unsigned char* lds, const bf16_t* qi, const bf16_t* ki, const float* wi, unsigned* mask) {
    for (int pr = blockIdx.x; pr < 256; pr += gridDim.x) {
        const int b = pr >> 6, ip = pr & 63;
        uint4 pfq[4]; float pfw = 0.f;
#pragma unroll
        for (int r = 0; r < 4; ++r) pfq[r] = make_uint4(0u, 0u, 0u, 0u);
#pragma unroll 1
        for (int w4 = 0; w4 < 4; ++w4) {
            const int qb = (w4 == 0) ? ip : (w4 == 1) ? 255 - ip : (w4 == 2) ? 127 - ip : 128 + ip;
            const int q0 = qb * 16; const size_t tok0 = (size_t)b * S_ + q0;
            {
                const int tid = fresh_tid();
                unsigned char* dst0 = lds + (tid >> 7) * 2064 + (tid & 127) * 16;
                if (w4 == 0) { const unsigned char* src0 = (const unsigned char*)(qi + tok0 * 1024) + (tid >> 7) * 2048 + (tid & 127) * 16;
#pragma unroll
                    for (int r = 0; r < 4; ++r) pfq[r] = *(const uint4*)(src0 + r * 4 * 2048);
                    pfw = tid < 256 ? wi[(tok0 + (tid >> 4)) * 16 + (tid & 15)] : 0.f; }
#pragma unroll
                for (int r = 0; r < 4; ++r) *(uint4*)(dst0 + r * 4 * 2064) = pfq[r];
                if (tid < 256) { const int qq = tid >> 4, hh = tid & 15; ((float*)(lds + 33024))[hh * 16 + qq] = pfw; }
            }
            __syncthreads();
            const int tid = fresh_tid(), wv = tid >> 6, lane = tid & 63, qq = lane & 15, grp = lane >> 4;
            const int qpos = q0 + qq;
            unsigned key[128];
            {
                const unsigned char* qrow = lds + qq * 2064 + grp * 16; const float* wl = (const float*)(lds + 33024) + qq;
                const unsigned char* kbase = (const unsigned char*)(ki + ((size_t)b * S_ + qq) * 64) + grp * 16;
#define IDX_LDQ(q0_, q1_, w_, h_) do { (q0_) = *(const bf16x8*)(qrow + (h_) * 128); (q1_) = *(const bf16x8*)(qrow + (h_) * 128 + 64); (w_) = wl[(h_) * 16]; } while (0)
#define IDX_MM(X_, q0_, q1_) do { _Pragma("unroll") for (int i = 0; i < 2; ++i) (X_)[i] = MFMA16(kf[i][0], (q0_), ((f32x4v){0.f, 0.f, 0.f, 0.f})); \
                                  _Pragma("unroll") for (int i = 0; i < 2; ++i) (X_)[i] = MFMA16(kf[i][1], (q1_), (X_)[i]); } while (0)
#define IDX_ACC(X_, w_) do { _Pragma("unroll") for (int i = 0; i < 2; ++i) _Pragma("unroll") for (int j = 0; j < 4; ++j) sacc[i][j] += (w_) * relu1((X_)[i][j]); } while (0)
#define IDX_LOADKF(dst_, tp_) do { const int kt0_ = wv + 16 * (tp_); _Pragma("unroll") for (int i = 0; i < 2; ++i) { const int kti = kt0_ + 8 * i, ktc = kti <= qb ? kti : kt0_; \
                    (dst_)[i][0] = *(const bf16x8*)(kbase + (size_t)ktc * 2048); (dst_)[i][1] = *(const bf16x8*)(kbase + (size_t)ktc * 2048 + 64); } } while (0)
                bf16x8 kf[2][2], kfn[2][2];
#pragma unroll
                for (int i = 0; i < 2; ++i) { kf[i][0] = (bf16x8){0, 0, 0, 0, 0, 0, 0, 0}; kf[i][1] = kf[i][0]; kfn[i][0] = kf[i][0]; kfn[i][1] = kf[i][0]; }
                if (wv <= qb) IDX_LOADKF(kf, 0);
#pragma unroll
                for (int tp = 0; tp < 16; ++tp) {
                    const int kt0 = wv + 16 * tp;
                    if (tp + 1 < 16 && kt0 + 16 <= qb) IDX_LOADKF(kfn, tp + 1);
                    if (kt0 <= qb) {
                        f32x4v sacc[2];
#pragma unroll
                        for (int i = 0; i < 2; ++i) sacc[i] = (f32x4v){0.f, 0.f, 0.f, 0.f};
                        {
                        f32x4v accA[2], accB[2]; bf16x8 qx0, qx1, qy0, qy1; float wA, wB, wx, wy;
                        IDX_LDQ(qy0, qy1, wA, 0); IDX_LDQ(qx0, qx1, wx, 1);
                        IDX_MM(accA, qy0, qy1);
#pragma unroll 1
                        for (int hh = 0; hh < 7; ++hh) {
                            IDX_LDQ(qy0, qy1, wy, 2 * hh + 2);
                            __builtin_amdgcn_sched_barrier(0);
                            IDX_MM(accB, qx0, qx1); wB = wx;
                            IDX_ACC(accA, wA);
                            __builtin_amdgcn_sched_barrier(0);
                            IDX_LDQ(qx0, qx1, wx, 2 * hh + 3);
                            __builtin_amdgcn_sched_barrier(0);
                            IDX_MM(accA, qy0, qy1); wA = wy;
                            IDX_ACC(accB, wB);
                            __builtin_amdgcn_sched_barrier(0);
                        }
                        IDX_MM(accB, qx0, qx1);
                        IDX_ACC(accA, wA);
                        IDX_ACC(accB, wx);
                        }
#pragma unroll
                        for (int i = 0; i < 2; ++i)
#pragma unroll
                            for (int j = 0; j < 4; ++j) { const int kp = 16 * (kt0 + 8 * i) + 4 * grp + j;
                                key[8 * tp + 4 * i + j] = (kt0 + 8 * i <= qb && kp <= qpos) ? f2key(sacc[i][j]) : 0u; }
                    } else {
#pragma unroll
                        for (int j = 0; j < 8; ++j) key[8 * tp + j] = 0u;
                    }
#pragma unroll
                    for (int i = 0; i < 2; ++i) { kf[i][0] = kfn[i][0]; kf[i][1] = kfn[i][1]; }
                }
#undef IDX_LOADKF
#undef IDX_LDQ
#undef IDX_MM
#undef IDX_ACC
            }
            if (w4 < 3) {
                const int qbn = (w4 == 0) ? 255 - ip : (w4 == 1) ? 127 - ip : 128 + ip; const size_t tokn = (size_t)b * S_ + qbn * 16;
                const unsigned char* srcn = (const unsigned char*)(qi + tokn * 1024) + (tid >> 7) * 2048 + (tid & 127) * 16;
#pragma unroll
                for (int r = 0; r < 4; ++r) pfq[r] = *(const uint4*)(srcn + r * 4 * 2048);
                pfw = tid < 256 ? wi[(tokn + (tid >> 4)) * 16 + (tid & 15)] : 0.f; }
            {
                unsigned* cb = (unsigned*)(lds + 34048);
                unsigned kmax = 0u, kmin1 = 0xFFFFFFFFu;
#pragma unroll
                for (int r = 0; r < 128; ++r) { kmax = key[r] > kmax ? key[r] : kmax; const unsigned k1 = key[r] - 1u; kmin1 = k1 < kmin1 ? k1 : kmin1; }
                { unsigned a = __shfl_xor(kmax, 16); kmax = a > kmax ? a : kmax; a = __shfl_xor(kmax, 32); kmax = a > kmax ? a : kmax;
                  unsigned c = __shfl_xor(kmin1, 16); kmin1 = c < kmin1 ? c : kmin1; c = __shfl_xor(kmin1, 32); kmin1 = c < kmin1 ? c : kmin1; }
                if (lane < 16) { cb[256 + wv * 16 + lane] = kmax; cb[384 + wv * 16 + lane] = kmin1; }
                __syncthreads();
#pragma unroll
                for (int w = 0; w < 8; ++w) { const unsigned a = cb[256 + w * 16 + qq], c = cb[384 + w * 16 + qq]; kmax = a > kmax ? a : kmax; kmin1 = c < kmin1 ? c : kmin1; }
                unsigned lo = kmin1, hi = kmax; bool done = false; int it = 0, side = 0;
                unsigned cntlo = (unsigned)(qpos + 1), cnthi = 0u;
                const float rn = __builtin_amdgcn_rcpf((float)(qpos + 1)), zt = zscore_of_count(256.0f, rn);
                float glo = zt - zscore_of_count((float)(qpos + 1) - 0.5f, rn), ghi = zt - zscore_of_count(0.5f, rn);
                if (qpos < 256) { hi = 0u; done = true; }
                while (!__all(done)) {
                    unsigned mid = lo + ((hi - lo) >> 1);
                    { const float flo = key2f(lo), fhi = key2f(hi); const unsigned dd = cntlo - cnthi;
                      const float fr = dd <= 200u ? (float)(cntlo - 256u) * __builtin_amdgcn_rcpf((float)dd) : glo / (glo - ghi);
                      const float xf = flo + (fhi - flo) * fr;
                      const unsigned kx = f2key(xf); if (kx > lo && kx < hi && (it & 15) != 15) mid = kx; }
                    unsigned c = 0u;
#pragma unroll
                    for (int r = 0; r < 128; ++r) c += (key[r] > mid) ? 1u : 0u;
                    c += __shfl_xor(c, 16); c += __shfl_xor(c, 32);
                    unsigned* cbi = cb + (it & 1) * 128;
                    if (lane < 16) cbi[wv * 16 + lane] = c;
                    __syncthreads();
                    unsigned tot = 0u;
#pragma unroll
                    for (int w = 0; w < 8; ++w) tot += cbi[w * 16 + qq];
                    if (!done) { const float g = zt - zscore_of_count(tot > 0u ? (float)tot : 0.5f, rn);
                        if (tot > 256u) { lo = mid; glo = g; cntlo = tot; if (side == 1) ghi *= 0.5f; side = 1; }
                        else { hi = mid; ghi = g; cnthi = tot; if (side == 2) glo *= 0.5f; side = 2; if (tot == 256u) done = true; }
                        if (hi - lo <= 1u) done = true; }
                    ++it;
                }
                unsigned short* mrow = (unsigned short*)(mask + (tok0 + qq) * 128);
#pragma unroll
                for (int t = 0; t < 32; ++t) { unsigned v = 0u;
#pragma unroll
                    for (int j = 0; j < 4; ++j) v |= (key[4 * t + j] > hi) ? (1u << j) : 0u;
                    v <<= 4 * grp; v |= __shfl_xor(v, 16); v |= __shfl_xor(v, 32);
                    if (lane < 16) mrow[wv + 8 * t] = (unsigned short)v; }
            }
            __syncthreads();
        }
    }
}
template <int DQK, bool MASKED>
__device__ __forceinline__ void attn_qblock(unsigned char* lds, const bf16_t* Qh, int ldq, const bf16_t* Kh, int ldk, const bf16_t* Kpe, const bf16_t* Vth, const unsigned* mask, bf16_t* outh, int b, int q0) {
    constexpr int NKK = DQK / 16, PPR = DQK / 8, NPK = 64 * PPR / 512, KSTR = DQK * 2 + 16, VSTR = 136, KBUF = 64 * KSTR, VBUF = 128 * VSTR, VOFF = 2 * KBUF;
    const int tid = fresh_tid(), wv = tid >> 6, lane = tid & 63, ql = lane & 31, half = lane >> 5;
    const int qpos = q0 + 32 * wv + ql; const size_t tq = (size_t)b * S_ + qpos;
    const bool late = wv >= 4;
    bf16x8 qf[NKK];
    f32x16 o[4];
#pragma unroll
    for (int dt = 0; dt < 4; ++dt)
#pragma unroll
        for (int e = 0; e < 16; ++e) o[dt][e] = 0.f;
    float m = -1e30f, l = 0.f;
    const int ntiles = (q0 + 256) / 64;
    bf16x8 pb0, pb1, pb2, pb3;
#pragma unroll
    for (int j = 0; j < 8; ++j) { pb0[j] = 0; pb1[j] = 0; pb2[j] = 0; pb3[j] = 0; }
    uint4 kreg0, kreg1, kreg2, vreg0, vreg1; kreg2.x = kreg2.y = kreg2.z = kreg2.w = 0u;
#define ATT_KSRC(r_, it_) ({ const int pp_ = tid + 512 * (r_), row_ = pp_ / PPR, pc_ = pp_ % PPR; const size_t tok_ = (size_t)b * S_ + (it_) * 64 + row_; \
        (const uint4*)((pc_ < 16) ? Kh + tok_ * ldk + 8 * pc_ : Kpe + tok_ * 64 + 8 * (pc_ - 16)); })
#define ATT_VSRC(r_, it_) ({ const int pp_ = tid + 512 * (r_), row_ = pp_ >> 3, pc_ = pp_ & 7; (const uint4*)(Vth + (size_t)row_ * T_ + (size_t)b * S_ + (it_) * 64 + 8 * pc_); })
#define ATT_LOADG(it_) do { kreg0 = *ATT_KSRC(0, it_); kreg1 = *ATT_KSRC(1, it_); if (NPK == 3) kreg2 = *ATT_KSRC(2, it_); vreg0 = *ATT_VSRC(0, it_); vreg1 = *ATT_VSRC(1, it_); } while (0)
#define ATT_KDST(r_, base_) ({ const int pp_ = tid + 512 * (r_), row_ = pp_ / PPR, pc_ = pp_ % PPR; (uint4*)((base_) + row_ * KSTR + pc_ * 16); })
#define ATT_VST(r_, base_, v_) do { const int pp_ = tid + 512 * (r_), row_ = pp_ >> 3, pc_ = pp_ & 7; uint2 a_, b_; a_.x = (v_).x; a_.y = (v_).y; b_.x = (v_).z; b_.y = (v_).w; \
        *(uint2*)((base_) + row_ * VSTR + pc_ * 16) = a_; *(uint2*)((base_) + row_ * VSTR + pc_ * 16 + 8) = b_; } while (0)
#define ATT_STOREL(kb_, vb_) do { unsigned char* kbase_ = lds + (kb_) * KBUF; unsigned char* vbase_ = lds + VOFF + (vb_) * VBUF; *ATT_KDST(0, kbase_) = kreg0; *ATT_KDST(1, kbase_) = kreg1; if (NPK == 3) *ATT_KDST(2, kbase_) = kreg2; \
        ATT_VST(0, vbase_, vreg0); ATT_VST(1, vbase_, vreg1); } while (0)
#define ATT_QKSM(kb_, it_) do { const unsigned char* kb = lds + (kb_) * KBUF; const int s0 = (it_) * 64; \
        f32x16 st0, st1; \
        _Pragma("unroll") for (int e = 0; e < 16; ++e) { st0[e] = 0.f; st1[e] = 0.f; } \
        { const unsigned char* kp0 = kb + ql * KSTR + 16 * half; const unsigned char* kp1 = kp0 + 32 * KSTR; bf16x8 ka[2][4]; \
          ka[0][0] = *(const bf16x8*)(kp0); ka[0][1] = *(const bf16x8*)(kp1); ka[0][2] = *(const bf16x8*)(kp0 + 32); ka[0][3] = *(const bf16x8*)(kp1 + 32); \
          __builtin_amdgcn_sched_barrier(0); \
          _Pragma("unroll") for (int c = 0; c < NKK / 2; ++c) { \
            if (c + 1 < NKK / 2) { ka[(c + 1) & 1][0] = *(const bf16x8*)(kp0 + 64 * (c + 1)); ka[(c + 1) & 1][1] = *(const bf16x8*)(kp1 + 64 * (c + 1)); \
                                   ka[(c + 1) & 1][2] = *(const bf16x8*)(kp0 + 64 * (c + 1) + 32); ka[(c + 1) & 1][3] = *(const bf16x8*)(kp1 + 64 * (c + 1) + 32); } \
            __builtin_amdgcn_sched_barrier(0); \
            st0 = MFMA32(ka[c & 1][0], qf[2 * c], st0); st1 = MFMA32(ka[c & 1][1], qf[2 * c], st1); st0 = MFMA32(ka[c & 1][2], qf[2 * c + 1], st0); st1 = MFMA32(ka[c & 1][3], qf[2 * c + 1], st1); \
            __builtin_amdgcn_sched_barrier(0); } } \
        if (MASKED) { const uint2 mw = mwcur; const unsigned w0 = mw.x >> (4 * half), w1 = mw.y >> (4 * half); \
            _Pragma("unroll") for (int e = 0; e < 16; ++e) { const int bit = (e & 3) + 8 * (e >> 2); st0[e] = ((w0 >> bit) & 1u) ? st0[e] : -INFINITY; st1[e] = ((w1 >> bit) & 1u) ? st1[e] : -INFINITY; } \
        } else if (s0 + 63 > q0 + 32 * wv) { \
            _Pragma("unroll") for (int e = 0; e < 16; ++e) { const int key0 = s0 + (e & 3) + 8 * (e >> 2) + 4 * half; if (key0 > qpos) st0[e] = -INFINITY; if (key0 + 32 > qpos) st1[e] = -INFINITY; } \
        } \
        float mx = fmaxf(st0[0], st1[0]); \
        _Pragma("unroll") for (int e = 1; e < 16; ++e) mx = fmaxf(mx, fmaxf(st0[e], st1[e])); \
        mx = fmaxf(mx, __shfl_xor(mx, 32)); \
          \
        const bool keep = __all(mx - m <= 8.0f); float alpha = 1.0f; \
        if (!keep) { const float mnew = fmaxf(m, mx); alpha = __builtin_amdgcn_exp2f(m - mnew); m = mnew; } \
        float ps = 0.f; \
        _Pragma("unroll") for (int e = 0; e < 16; ++e) { st0[e] = __builtin_amdgcn_exp2f(st0[e] - m); st1[e] = __builtin_amdgcn_exp2f(st1[e] - m); ps += st0[e] + st1[e]; } \
        l = l * alpha + ps; \
        if (!keep) { \
            _Pragma("unroll") for (int dt = 0; dt < 4; ++dt) \
                _Pragma("unroll") for (int e = 0; e < 16; ++e) o[dt][e] *= alpha; } \
        { u32x4_t pw; \
          pw.x = pk2(st0[0], st0[1]); pw.y = pk2(st0[2], st0[3]); pw.z = pk2(st0[4], st0[5]); pw.w = pk2(st0[6], st0[7]); pb0 = __builtin_bit_cast(bf16x8, pw); \
          pw.x = pk2(st0[8], st0[9]); pw.y = pk2(st0[10], st0[11]); pw.z = pk2(st0[12], st0[13]); pw.w = pk2(st0[14], st0[15]); pb1 = __builtin_bit_cast(bf16x8, pw); \
          pw.x = pk2(st1[0], st1[1]); pw.y = pk2(st1[2], st1[3]); pw.z = pk2(st1[4], st1[5]); pw.w = pk2(st1[6], st1[7]); pb2 = __builtin_bit_cast(bf16x8, pw); \
          pw.x = pk2(st1[8], st1[9]); pw.y = pk2(st1[10], st1[11]); pw.z = pk2(st1[12], st1[13]); pw.w = pk2(st1[14], st1[15]); pb3 = __builtin_bit_cast(bf16x8, pw); } \
    } while (0)
#define ATT_LDV(dst_, vbp_, g_) do { _Pragma("unroll") for (int dt = 0; dt < 4; ++dt) { const unsigned char* vp = (vbp_) + (32 * dt + ql) * VSTR + (16 * (g_) + 4 * half) * 2; \
            const s16x4 lo = *(const s16x4*)vp, hi = *(const s16x4*)(vp + 16); (dst_)[dt] = __builtin_shufflevector(lo, hi, 0, 1, 2, 3, 4, 5, 6, 7); } } while (0)
#define ATT_MMV(src_, pb_) do { _Pragma("unroll") for (int dt = 0; dt < 4; ++dt) o[dt] = MFMA32((src_)[dt], (pb_), o[dt]); } while (0)
#define ATT_PV(vb_) do { const unsigned char* vbp = lds + VOFF + (vb_) * VBUF; bf16x8 va[2][4]; \
        ATT_LDV(va[0], vbp, 0); __builtin_amdgcn_sched_barrier(0); \
        ATT_LDV(va[1], vbp, 1); __builtin_amdgcn_sched_barrier(0); ATT_MMV(va[0], pb0); __builtin_amdgcn_sched_barrier(0); \
        ATT_LDV(va[0], vbp, 2); __builtin_amdgcn_sched_barrier(0); ATT_MMV(va[1], pb1); __builtin_amdgcn_sched_barrier(0); \
        ATT_LDV(va[1], vbp, 3); __builtin_amdgcn_sched_barrier(0); ATT_MMV(va[0], pb2); __builtin_amdgcn_sched_barrier(0); \
        ATT_MMV(va[1], pb3); __builtin_amdgcn_sched_barrier(0); } while (0)
    ATT_LOADG(0);
#pragma unroll
    for (int kk = 0; kk < NKK; ++kk) qf[kk] = *(const bf16x8*)(Qh + tq * ldq + 16 * kk + 8 * half);
    ATT_STOREL(0, 0); if (ntiles > 1) ATT_LOADG(1);
    uint2 mwcur = make_uint2(0u, 0u), mwnext = make_uint2(0u, 0u);
    if (MASKED) mwcur = *(const uint2*)(mask + tq * 128);
    const int qmaxw = q0 + 32 * wv + 31;
    int vcur = 0, vprev = 2;
    for (int it = 0; it < ntiles; ++it) {
        const int vnext = vcur == 2 ? 0 : vcur + 1;
        __syncthreads();
        if (it + 1 < ntiles) { ATT_STOREL((it + 1) & 1, vnext); if (it + 2 < ntiles) ATT_LOADG(it + 2); }
        if (MASKED && it + 1 < ntiles) mwnext = *(const uint2*)(mask + tq * 128 + 2 * (it + 1));
        const bool vis = it * 64 <= qmaxw;
        if (!late) { if (vis) { ATT_QKSM(it & 1, it); ATT_PV(vcur); } }
        else { if (it > 0 && (it - 1) * 64 <= qmaxw) ATT_PV(vprev); if (vis) ATT_QKSM(it & 1, it); }
        vprev = vcur; vcur = vnext; mwcur = mwnext;
    }
    if (late && (ntiles - 1) * 64 <= qmaxw) ATT_PV(vprev);
    __syncthreads();
#undef ATT_LOADG
#undef ATT_STOREL
#undef ATT_KSRC
#undef ATT_VSRC
#undef ATT_KDST
#undef ATT_VST
#undef ATT_QKSM
#undef ATT_LDV
#undef ATT_MMV
#undef ATT_PV
    l += __shfl_xor(l, 32); const float inv = 1.0f / l;
#pragma unroll
    for (int dt = 0; dt < 4; ++dt)
#pragma unroll
        for (int g = 0; g < 4; ++g) { uint2 w; w.x = pk2(o[dt][4 * g] * inv, o[dt][4 * g + 1] * inv); w.y = pk2(o[dt][4 * g + 2] * inv, o[dt][4 * g + 3] * inv);
            *(uint2*)(outh + tq * 2048 + 32 * dt + 8 * g + 4 * half) = w; }
}
__device__ __forceinline__ void attn_job(unsigned char* lds, unsigned char* ws) {
    const bf16_t *qa = (const bf16_t*)(ws + OFF_QA), *ka = (const bf16_t*)(ws + OFF_KA), *vta = (const bf16_t*)(ws + OFF_VTA), *qm = (const bf16_t*)(ws + OFF_QM), *kn = (const bf16_t*)(ws + OFF_KNOPE),
                 *kr = (const bf16_t*)(ws + OFF_KR), *vtb = (const bf16_t*)(ws + OFF_VTB); const unsigned* mask = (const unsigned*)(ws + OFF_MASK); bf16_t* ao = (bf16_t*)(ws + OFF_AO);
    for (int u = blockIdx.x; u < 512; u += gridDim.x) {
        const int type = u >> 8, r0 = u & 255, r = (r0 & 7) * 32 + (r0 >> 3), bh = r >> 3, pair = r & 7, b = bh >> 3, h = bh & 7;
        if (type == 0) { for (int w2 = 0; w2 < 2; ++w2) attn_qblock<128, true>(lds, qa + h * 128, 1024, ka + h * 128, 1024, ka, vta + (size_t)h * 128 * T_, mask, ao + h * 128, b, (w2 ? pair : 15 - pair) * 256); }
        else { for (int w2 = 0; w2 < 2; ++w2) attn_qblock<192, false>(lds, qm + h * 192, 1536, kn + h * 128, 1024, kr, vtb + (size_t)h * 128 * T_, mask, ao + 1024 + h * 128, b, (w2 ? pair : 15 - pair) * 256); }
    }
}
#define XB_XCNT(j) (64 * (j))
#define XB_XSUB(j) (1024 + 64 * (j))
#define XB_XGEN(j) (2048 + 64 * (j))
#define XB_TOP 3072
#define XB_TOPGEN 3136
__device__ __forceinline__ unsigned xb_ld(unsigned* p) { return __hip_atomic_load(p, __ATOMIC_RELAXED, __HIP_MEMORY_SCOPE_AGENT); }
__device__ __forceinline__ unsigned xb_add(unsigned* p, unsigned v) { return __hip_atomic_fetch_add(p, v, __ATOMIC_RELAXED, __HIP_MEMORY_SCOPE_AGENT); }
__device__ __forceinline__ unsigned xb_xcc_id() { return (unsigned)__builtin_amdgcn_s_getreg((3 << 11) | 20) & 0xFu; }
__device__ __forceinline__ void grid_bar(unsigned* bar, unsigned x, unsigned nloc, unsigned nx, unsigned k) {
    asm volatile("s_waitcnt vmcnt(0)" ::: "memory");
    __syncthreads();
    if (threadIdx.x == 0) {
        const unsigned old = xb_add(&bar[XB_XSUB(x)], 1u);
        if (old + 1u == k * nloc) {
            __builtin_amdgcn_fence(__ATOMIC_RELEASE, "agent");
            asm volatile("s_waitcnt vmcnt(0)" ::: "memory");
            const unsigned og = xb_add(&bar[XB_TOP], 1u);
            if (og + 1u == k * nx) xb_add(&bar[XB_TOPGEN], 1u);
            else while (xb_ld(&bar[XB_TOPGEN]) < k) __builtin_amdgcn_s_sleep(1);
            __builtin_amdgcn_fence(__ATOMIC_ACQUIRE, "agent");
            xb_add(&bar[XB_XGEN(x)], 1u);
            asm volatile("s_waitcnt vmcnt(0)" ::: "memory");
        } else {
            while (xb_ld(&bar[XB_XGEN(x)]) < k) __builtin_amdgcn_s_sleep(1);
            __builtin_amdgcn_fence(__ATOMIC_ACQUIRE, "agent");
            asm volatile("s_waitcnt vmcnt(0)" ::: "memory");
        }
    }
    __syncthreads();
}
#ifndef GEMM_SEL
#define GEMM_SEL 127
#endif
#ifndef GEMM_ALIGN
#define GEMM_ALIGN true
#endif
#ifndef GEMM_SP2
#define GEMM_SP2 true
#endif
extern __shared__ __attribute__((aligned(16))) unsigned char dyn_lds[];
template <class Epi> __device__ __forceinline__ void run_gemm(const bf16_t* A, const bf16_t* Bt, int M, int N, int K, const Epi& E) {
    asm volatile("" : "+s"(M), "+s"(N), "+s"(K));
    pg8::Gemm g; g.A = A; g.Bt = Bt; g.M = M; g.N = N; g.K = K;
    pg8::StaticOrder S; S.init(M, N, (int)gridDim.x, (int)blockIdx.x);
#ifndef NO_GEMM
    if constexpr ((GEMM_SEL & Epi::ID) != 0) pg8::gemm_phase<Epi, pg8::StaticOrder, GEMM_ALIGN, GEMM_SP2>((PG8_LAS unsigned char*)dyn_lds, g, S, E);
#endif
}
__global__ void __launch_bounds__(512) mega(const Params p) {
    cg::grid_group grid = cg::this_grid();
    unsigned char* lds = dyn_lds; unsigned char* ws = p.ws;
    bf16_t* xb = (bf16_t*)(ws + OFF_XB); float* rt = (float*)(ws + OFF_RT);
    unsigned* barw = (unsigned*)(ws + OFF_BAR); const unsigned xcc = xb_xcc_id();
    if (threadIdx.x == 0) (void)xb_add(&barw[XB_XCNT(xcc)], 1u);
#ifndef NO_MISC
    rope_table_job(p.pos, rt);
    x_to_bf16_job(p.x, xb);
    conv_attn_weights(lds, p, 0);
#endif
    grid.sync();
    unsigned nbar = 0u, nloc = 1u, nxcd = 0u;
    for (unsigned j = 0; j < 16; ++j) { const unsigned c = xb_ld(&barw[XB_XCNT(j)]); nxcd += c > 0u ? 1u : 0u; nloc = (j == xcc) ? c : nloc; }
#pragma unroll 1
    for (int l = 0; l < 2; ++l) {
        {
            pg8::EpiInMain e; e.qa = (bf16_t*)(ws + OFF_QA); e.ka = (bf16_t*)(ws + OFF_KA); e.qi = (bf16_t*)(ws + OFF_QI); e.cq = (bf16_t*)(ws + OFF_CQ); e.ckv = (bf16_t*)(ws + OFF_CKV);
            e.ki = (bf16_t*)(ws + OFF_KI); e.kr = (bf16_t*)(ws + OFF_KR); e.wi = (float*)(ws + OFF_WI); e.rsq = (float*)(ws + OFF_RSQ); e.rskv = (float*)(ws + OFF_RSKV); e.rt = rt;
            run_gemm(xb, (const bf16_t*)(ws + OFF_WIN), T_, 4096, DM_, e);
            pg8::EpiPlainBf16 ev; ev.O = (bf16_t*)(ws + OFF_VTA); ev.ldc = T_;
            run_gemm((const bf16_t*)(ws + OFF_WVA), xb, 1024, T_, DM_, ev);
        }
        grid_bar(barw, xcc, nloc, nxcd, ++nbar);
        {
            pg8::EpiUq eq; eq.O = (bf16_t*)(ws + OFF_QM); eq.rsq = (const float*)(ws + OFF_RSQ); eq.rt = rt;
            run_gemm((const bf16_t*)(ws + OFF_CQ), (const bf16_t*)(ws + OFF_WUQ), T_, 1536, 512, eq);
            pg8::EpiUkvK ek; ek.O = (bf16_t*)(ws + OFF_KNOPE); ek.rskv = (const float*)(ws + OFF_RSKV);
            run_gemm((const bf16_t*)(ws + OFF_CKV), (const bf16_t*)(ws + OFF_WUKK), T_, 1024, 256, ek);
            pg8::EpiUkvV ev; ev.O = (bf16_t*)(ws + OFF_VTB); ev.rskv = (const float*)(ws + OFF_RSKV);
            run_gemm((const bf16_t*)(ws + OFF_WUKV), (const bf16_t*)(ws + OFF_CKV), 1024, T_, 256, ev);
#ifndef NO_IDX
            indexer_job(lds, (const bf16_t*)(ws + OFF_QI), (const bf16_t*)(ws + OFF_KI), (const float*)(ws + OFF_WI), (unsigned*)(ws + OFF_MASK));
#endif
        }
        grid_bar(barw, xcc, nloc, nxcd, ++nbar);
#ifndef NO_ATTN
        attn_job(lds, ws);
#endif
        grid_bar(barw, xcc, nloc, nxcd, ++nbar);
        {
            pg8::EpiResB e; e.Y = (bf16_t*)(ws + OFF_QA); e.X = xb;
            run_gemm((const bf16_t*)(ws + OFF_AO), (const bf16_t*)(ws + OFF_WO), T_, DM_, DM_, e);
        }
        grid_bar(barw, xcc, nloc, nxcd, ++nbar);
#ifndef NO_MISC
        conv_ffn_weights(lds, p, l);
        ln_job((const bf16_t*)(ws + OFF_QA), p.ln1_g + l * DM_, p.ln1_b + l * DM_, xb, nullptr);
#endif
        grid_bar(barw, xcc, nloc, nxcd, ++nbar);
        {
            pg8::EpiGU e; e.O = (bf16_t*)(ws + OFF_QA);
            run_gemm(xb, (const bf16_t*)(ws + OFF_WGU), T_, 2 * FF_, DM_, e);
        }
        grid_bar(barw, xcc, nloc, nxcd, ++nbar);
        {
            pg8::EpiResB e; e.Y = (bf16_t*)(ws + OFF_AO); e.X = xb;
            run_gemm((const bf16_t*)(ws + OFF_QA), (const bf16_t*)(ws + OFF_WDN), T_, DM_, FF_, e);
        }
        grid_bar(barw, xcc, nloc, nxcd, ++nbar);
#ifndef NO_MISC
        if (l + 1 < 2) conv_attn_weights(lds, p, l + 1);
        ln_job((const bf16_t*)(ws + OFF_AO), p.ln2_g + l * DM_, p.ln2_b + l * DM_, l + 1 < 2 ? xb : nullptr, l + 1 < 2 ? nullptr : p.out);
#endif
        grid_bar(barw, xcc, nloc, nxcd, ++nbar);
    }
}

extern "C" void kernel_launch(void* const* d_in, const int* in_sizes, int n_in, void* d_out, int out_size, void* d_ws, size_t ws_size, hipStream_t stream) {
    constexpr size_t kDynLds = 131072;
    static int grid_blocks = 0;
    if (!grid_blocks) {
        int dev = 0, cus = 0, per_cu = 0;
        (void)hipGetDevice(&dev);
        (void)hipDeviceGetAttribute(&cus, hipDeviceAttributeMultiprocessorCount, dev);
        (void)hipFuncSetAttribute((const void*)mega, hipFuncAttributeMaxDynamicSharedMemorySize, (int)kDynLds);
        (void)hipOccupancyMaxActiveBlocksPerMultiprocessor(&per_cu, mega, 512, kDynLds);
        if (per_cu < 1) per_cu = 1;
        grid_blocks = cus;
    }
    (void)hipMemsetAsync((unsigned char*)d_ws + OFF_BAR, 0, 16384, stream);
    Params p{};
    p.x = (const float*)d_in[0]; p.pos = (const int*)d_in[1]; p.w_in = (const float*)d_in[2]; p.g_cq = (const float*)d_in[3]; p.g_ckv = (const float*)d_in[4];
    p.w_uq = (const float*)d_in[5]; p.w_ukv = (const float*)d_in[6]; p.w_o = (const float*)d_in[7]; p.ln1_g = (const float*)d_in[8]; p.ln1_b = (const float*)d_in[9];
    p.w_gate = (const float*)d_in[10]; p.w_up = (const float*)d_in[11]; p.w_down = (const float*)d_in[12]; p.ln2_g = (const float*)d_in[13]; p.ln2_b = (const float*)d_in[14];
    p.out = (float*)d_out; p.ws = (unsigned char*)d_ws;
    void* args[] = {&p};
    hipError_t e = hipLaunchCooperativeKernel((void*)mega, dim3(grid_blocks), dim3(512), args, kDynLds, stream);
    if (e != hipSuccess) fprintf(stderr, "cooperative launch failed: %s (grid %d)\n", hipGetErrorString(e), grid_blocks);
}
```

```cpp
#include <hip/hip_runtime.h>
#include <hip/hip_cooperative_groups.h>
#include <cstdio>
namespace cg = cooperative_groups;

constexpr int T_ = 16384, S_ = 4096, NB_ = 4, DM_ = 2048, FF_ = 5632, INC_ = 5008;
constexpr float LOG2E_ = 1.4426950408889634f;
constexpr float QA_SCALE_ = 0.08838834764831845f * LOG2E_;
constexpr float QM_SCALE_ = 0.07216878364870323f * LOG2E_;
constexpr float ALPHA_ = 1.4142135623730951f;
constexpr int RTW_ = 112;

typedef __bf16 bf16x2_t __attribute__((ext_vector_type(2)));
typedef float f32x2_t __attribute__((ext_vector_type(2)));
__device__ __forceinline__ unsigned pk2(float a, float b) { f32x2_t v = {a, b}; bf16x2_t r = __builtin_convertvector(v, bf16x2_t); return __builtin_bit_cast(unsigned, r); }
__device__ __forceinline__ void rot2(float& a, float& b, float c, float s) { const float na = a * c - b * s, nb = b * c + a * s; a = na; b = nb; }

__device__ __forceinline__ int fresh_tid() { int t = (int)threadIdx.x; asm volatile("" : "+v"(t)); return t; }

namespace pg8 {
#define PG8_LAS __attribute__((address_space(3)))
typedef unsigned short bf16_t;
typedef short bf16x8 __attribute__((ext_vector_type(8)));
typedef float f32x4 __attribute__((ext_vector_type(4)));
typedef unsigned u32x4 __attribute__((ext_vector_type(4)));
constexpr int BM = 256, BK = 64, HALF = 128, HTB = HALF * BK * 2  , STAGE_BYTES = 8 * HTB, NXCD = 8, WGM = 8;

__host__ __device__ __forceinline__ int lds_byte(int r, int c) { const int st = (r >> 4) * 2 + (c >> 5), rr = r & 15, cc = c & 31, ob = rr * 64 + cc * 2; return st * 1024 + (ob ^ (((ob >> 9) & 1) << 5)); }
__host__ __device__ __forceinline__ void stage_rc(int b, int& R, int& C) { const int st = b / 1024, sb = b % 1024, swz = sb ^ (((sb >> 9) & 1) << 5); R = (st >> 1) * 16 + swz / 64; C = (st & 1) * 32 + (swz % 64) / 2; }
__host__ __device__ __forceinline__ int perm32(int rho) { const int n = rho >> 4, i = rho & 15; return 8 * (i >> 2) + 4 * n + (i & 3); }

struct Unit { int pm, pn; };
struct Gemm { const bf16_t* A; const bf16_t* Bt; int M, N, K; };

struct StaticOrder {
    int nM, nN, nwg, G, c;
    __host__ __device__ void init(int M, int N, int G_, int c_) { nM = M / BM; nN = N / BM; nwg = nM * nN; G = G_; c = c_; }
    __host__ __device__ bool next(int i, Unit& u) const {
        const long L = (long)i * G + c; if (L >= nwg) return false;
        int wgid = (int)L; { const int q = nwg / NXCD, r = nwg % NXCD, xcd = wgid % NXCD, off = wgid / NXCD; wgid = (xcd < r ? xcd * (q + 1) : r * (q + 1) + (xcd - r) * q) + off; }
        const int nig = WGM * nN, gid = wgid / nig, fm = gid * WGM, gsz = (nM - fm) < WGM ? (nM - fm) : WGM;
        u.pm = fm + ((wgid % nig) % gsz); u.pn = (wgid % nig) / gsz; return true;
    }
    __device__ __forceinline__ void a_ready(const Unit&) const {}
    __device__ __forceinline__ void done(const Unit&) const {}
};
typedef unsigned u32x4_t __attribute__((ext_vector_type(4)));
__device__ __forceinline__ u32x4_t pack8(const f32x4& v0, const f32x4& v1) { u32x4_t w; w.x = pk2(v0[0], v0[1]); w.y = pk2(v0[2], v0[3]); w.z = pk2(v1[0], v1[1]); w.w = pk2(v1[2], v1[3]); return w; }
__device__ __forceinline__ void rope4(f32x4& v0, f32x4& v1, const float* tab) {
    const f32x4 c0 = *(const f32x4*)tab, c1 = *(const f32x4*)(tab + 4);
    const float cs[4] = {c0[0], c0[2], c1[0], c1[2]}, sn[4] = {c0[1], c0[3], c1[1], c1[3]};
#pragma unroll
    for (int j = 0; j < 4; ++j) { const float a = v0[j], b = v1[j]; v0[j] = a * cs[j] - b * sn[j]; v1[j] = b * cs[j] + a * sn[j]; }
}
__device__ __forceinline__ void rope4v(f32x4& v0, f32x4& v1, const f32x4& c0, const f32x4& c1) {
    const float cs[4] = {c0[0], c0[2], c1[0], c1[2]}, sn[4] = {c0[1], c0[3], c1[1], c1[3]};
#pragma unroll
    for (int j = 0; j < 4; ++j) { const float a = v0[j], b = v1[j]; v0[j] = a * cs[j] - b * sn[j]; v1[j] = b * cs[j] + a * sn[j]; }
}
__device__ __forceinline__ float sumsq8(const f32x4& a, const f32x4& b) { return a[0]*a[0] + a[1]*a[1] + a[2]*a[2] + a[3]*a[3] + b[0]*b[0] + b[1]*b[1] + b[2]*b[2] + b[3]*b[3]; }

struct EpiInMain {
    static constexpr int ID = 1; static constexpr bool PERM = true, AFTER_DRAIN = false;
    bf16_t *qa, *ka, *qi, *cq, *ckv, *ki, *kr; float *wi, *rsq, *rskv; const float* rt;
    __device__ __forceinline__ void operator()(const f32x4 (&acc)[2][2][4][2], const Unit& u, int wr, int wc, int fr, int fq) const {
        const int row0 = u.pm * BM + wr * 64 + fr, pn = u.pn, cw = wc * 32 + 8 * fq;
        if (pn < 8) {
            bf16_t* O = pn < 4 ? qa : ka; const int colt = (pn & 3) * 256; const float sc = pn < 4 ? QA_SCALE_ : 1.0f;
#pragma unroll
            for (int ai = 0; ai < 2; ++ai) {
                f32x4 tb[4][2];
                if (wc == 0) {
#pragma unroll
                    for (int m = 0; m < 4; ++m) { const float* tp_ = rt + (size_t)(row0 + ai * HALF + m * 16) * RTW_ + 8 * fq; tb[m][0] = *(const f32x4*)tp_; tb[m][1] = *(const f32x4*)(tp_ + 4); } }
#pragma unroll
                for (int m = 0; m < 4; ++m) { const int row = row0 + ai * HALF + m * 16;
#pragma unroll
                    for (int bj = 0; bj < 2; ++bj) { f32x4 v0 = acc[ai][bj][m][0], v1 = acc[ai][bj][m][1];
                        if (wc == 0) rope4v(v0, v1, tb[m][0], tb[m][1]);
                        v0 *= sc; v1 *= sc;
                        *(u32x4_t*)(O + (size_t)row * 1024 + colt + bj * HALF + cw) = pack8(v0, v1); } } }
        } else if (pn < 12) {
            const int colt = (pn - 8) * 256; const bool rp = ((wc & 1) == 0) && (fq < 2);
#pragma unroll
            for (int ai = 0; ai < 2; ++ai) {
                f32x4 tb[4][2];
                if ((wc & 1) == 0) {
#pragma unroll
                    for (int m = 0; m < 4; ++m) { const float* tp_ = rt + (size_t)(row0 + ai * HALF + m * 16) * RTW_ + 96 + 8 * (fq & 1); tb[m][0] = *(const f32x4*)tp_; tb[m][1] = *(const f32x4*)(tp_ + 4); } }
#pragma unroll
                for (int m = 0; m < 4; ++m) { const int row = row0 + ai * HALF + m * 16;
#pragma unroll
                    for (int bj = 0; bj < 2; ++bj) { f32x4 v0 = acc[ai][bj][m][0], v1 = acc[ai][bj][m][1];
                        if (rp) rope4v(v0, v1, tb[m][0], tb[m][1]);
                        *(u32x4_t*)(qi + (size_t)row * 1024 + colt + bj * HALF + cw) = pack8(v0, v1); } } }
        } else if (pn < 15) {
            const bool isq = pn < 14; bf16_t* O = isq ? cq : ckv; const int ldo = isq ? 512 : 256, colt = isq ? (pn - 12) * 256 : 0;
#pragma unroll
            for (int ai = 0; ai < 2; ++ai)
#pragma unroll
                for (int m = 0; m < 4; ++m) { const int row = row0 + ai * HALF + m * 16; float ss = 0.f;
#pragma unroll
                    for (int bj = 0; bj < 2; ++bj) { const f32x4 v0 = acc[ai][bj][m][0], v1 = acc[ai][bj][m][1]; ss += sumsq8(v0, v1);
                        *(u32x4_t*)(O + (size_t)row * ldo + colt + bj * HALF + cw) = pack8(v0, v1); }
                    ss += __shfl_xor(ss, 16); ss += __shfl_xor(ss, 32);
                    if (fq == 0) { if (isq) rsq[(size_t)row * 8 + (pn - 12) * 4 + wc] = ss; else rskv[(size_t)row * 4 + wc] = ss; } }
        } else {
#pragma unroll
            for (int ai = 0; ai < 2; ++ai)
#pragma unroll
                for (int m = 0; m < 4; ++m) { const int row = row0 + ai * HALF + m * 16;
                    f32x4 v0 = acc[ai][0][m][0], v1 = acc[ai][0][m][1];
                    if (wc < 2) { if (wc == 0 && fq < 2) rope4(v0, v1, rt + (size_t)row * RTW_ + 96 + 8 * fq);
                        *(u32x4_t*)(ki + (size_t)row * 64 + cw) = pack8(v0, v1);
                    } else { const int p0 = cw - 64;
                        rope4(v0, v1, rt + (size_t)row * RTW_ + 32 + p0);
                        *(u32x4_t*)(kr + (size_t)row * 64 + p0) = pack8(v0, v1); }
                    if (wc == 0 && fq < 2) { const f32x4 w0 = acc[ai][1][m][0] * 0.03125f, w1 = acc[ai][1][m][1] * 0.03125f;
                        *(f32x4*)(wi + (size_t)row * 16 + 8 * fq) = w0; *(f32x4*)(wi + (size_t)row * 16 + 8 * fq + 4) = w1; } }
        }
    }
};
struct EpiPlainBf16 {
    static constexpr int ID = 2; static constexpr bool PERM = true, AFTER_DRAIN = false;
    bf16_t* O; int ldc;
    __device__ __forceinline__ void operator()(const f32x4 (&acc)[2][2][4][2], const Unit& u, int wr, int wc, int fr, int fq) const {
        const int row0 = u.pm * BM + wr * 64 + fr, col0 = u.pn * BM + wc * 32 + 8 * fq;
#pragma unroll
        for (int ai = 0; ai < 2; ++ai)
#pragma unroll
            for (int m = 0; m < 4; ++m) { bf16_t* rowp = O + (size_t)(row0 + ai * HALF + m * 16) * ldc + col0;
#pragma unroll
                for (int bj = 0; bj < 2; ++bj) *(u32x4_t*)(rowp + bj * HALF) = pack8(acc[ai][bj][m][0], acc[ai][bj][m][1]); }
    }
};
struct EpiUq {
    static constexpr int ID = 4; static constexpr bool PERM = true, AFTER_DRAIN = false;
    bf16_t* O; const float* rsq; const float* rt;
    __device__ __forceinline__ void operator()(const f32x4 (&acc)[2][2][4][2], const Unit& u, int wr, int wc, int fr, int fq) const {
        const int row0 = u.pm * BM + wr * 64 + fr;
#pragma unroll
        for (int ai = 0; ai < 2; ++ai) {
            f32x4 pq[4][2];
#pragma unroll
            for (int m = 0; m < 4; ++m) { const float* rp_ = rsq + (size_t)(row0 + ai * HALF + m * 16) * 8; pq[m][0] = *(const f32x4*)rp_; pq[m][1] = *(const f32x4*)(rp_ + 4); }
#pragma unroll
            for (int m = 0; m < 4; ++m) { const int row = row0 + ai * HALF + m * 16;
                const f32x4 p0 = pq[m][0], p1 = pq[m][1];
                const float ssum = ((p0[0] + p0[1]) + (p0[2] + p0[3])) + ((p1[0] + p1[1]) + (p1[2] + p1[3]));
                const float sc = __builtin_amdgcn_rsqf(ssum * (1.0f / 512.0f) + 1e-6f) * QM_SCALE_;
#pragma unroll
                for (int bj = 0; bj < 2; ++bj) { const int c = u.pn * BM + bj * HALF + wc * 32 + 8 * fq; const int within = c % 192;
                    f32x4 v0 = acc[ai][bj][m][0], v1 = acc[ai][bj][m][1];
                    if (within >= 128) rope4(v0, v1, rt + (size_t)row * RTW_ + 32 + (within - 128));
                    v0 *= sc; v1 *= sc;
                    *(u32x4_t*)(O + (size_t)row * 1536 + c) = pack8(v0, v1); } } }
    }
};
struct EpiUkvK {
    static constexpr int ID = 8; static constexpr bool PERM = true, AFTER_DRAIN = false;
    bf16_t* O; const float* rskv;
    __device__ __forceinline__ void operator()(const f32x4 (&acc)[2][2][4][2], const Unit& u, int wr, int wc, int fr, int fq) const {
        const int row0 = u.pm * BM + wr * 64 + fr, col0 = u.pn * BM + wc * 32 + 8 * fq;
#pragma unroll
        for (int ai = 0; ai < 2; ++ai) {
            f32x4 pk[4];
#pragma unroll
            for (int m = 0; m < 4; ++m) pk[m] = *(const f32x4*)(rskv + (size_t)(row0 + ai * HALF + m * 16) * 4);
#pragma unroll
            for (int m = 0; m < 4; ++m) { const int row = row0 + ai * HALF + m * 16;
                const f32x4 p0 = pk[m];
                const float sc = __builtin_amdgcn_rsqf(((p0[0] + p0[1]) + (p0[2] + p0[3])) * (1.0f / 256.0f) + 1e-6f);
#pragma unroll
                for (int bj = 0; bj < 2; ++bj) { f32x4 v0 = acc[ai][bj][m][0] * sc, v1 = acc[ai][bj][m][1] * sc;
                    *(u32x4_t*)(O + (size_t)row * 1024 + col0 + bj * HALF) = pack8(v0, v1); } } }
    }
};
struct EpiUkvV {
    static constexpr int ID = 16; static constexpr bool PERM = true, AFTER_DRAIN = false;
    bf16_t* O; const float* rskv;
    __device__ __forceinline__ void operator()(const f32x4 (&acc)[2][2][4][2], const Unit& u, int wr, int wc, int fr, int fq) const {
        const int row0 = u.pm * BM + wr * 64 + fr, col0 = u.pn * BM + wc * 32 + 8 * fq;
#pragma unroll
        for (int bj = 0; bj < 2; ++bj) { const int c = col0 + bj * HALF; f32x4 s0, s1;
#pragma unroll
            for (int j = 0; j < 4; ++j) { const f32x4 a = *(const f32x4*)(rskv + (size_t)(c + j) * 4), b = *(const f32x4*)(rskv + (size_t)(c + 4 + j) * 4);
                s0[j] = __builtin_amdgcn_rsqf(((a[0] + a[1]) + (a[2] + a[3])) * (1.0f / 256.0f) + 1e-6f);
                s1[j] = __builtin_amdgcn_rsqf(((b[0] + b[1]) + (b[2] + b[3])) * (1.0f / 256.0f) + 1e-6f); }
#pragma unroll
            for (int ai = 0; ai < 2; ++ai)
#pragma unroll
                for (int m = 0; m < 4; ++m) { const f32x4 v0 = acc[ai][bj][m][0] * s0, v1 = acc[ai][bj][m][1] * s1;
                    *(u32x4_t*)(O + (size_t)(row0 + ai * HALF + m * 16) * T_ + c) = pack8(v0, v1); } }
    }
};
__device__ __forceinline__ f32x4 bf16lo4(unsigned a, unsigned b) { f32x4 r; r[0] = __uint_as_float(a << 16); r[1] = __uint_as_float(a & 0xffff0000u); r[2] = __uint_as_float(b << 16); r[3] = __uint_as_float(b & 0xffff0000u); return r; }
struct EpiResB {
    static constexpr int ID = 32; static constexpr bool PERM = true, AFTER_DRAIN = false;
    bf16_t* Y; const bf16_t* X;
    __device__ __forceinline__ void operator()(const f32x4 (&acc)[2][2][4][2], const Unit& u, int wr, int wc, int fr, int fq) const {
        const int row0 = u.pm * BM + wr * 64 + fr, col0 = u.pn * BM + wc * 32 + 8 * fq;
        u32x4_t xw[2][4][2];
#pragma unroll
        for (int ai = 0; ai < 2; ++ai)
#pragma unroll
            for (int m = 0; m < 4; ++m)
#pragma unroll
                for (int bj = 0; bj < 2; ++bj) xw[ai][m][bj] = *(const u32x4_t*)(X + (size_t)(row0 + ai * HALF + m * 16) * DM_ + col0 + bj * HALF);
#pragma unroll
        for (int ai = 0; ai < 2; ++ai)
#pragma unroll
            for (int m = 0; m < 4; ++m) { const size_t ro = (size_t)(row0 + ai * HALF + m * 16) * DM_ + col0;
#pragma unroll
                for (int bj = 0; bj < 2; ++bj) { const u32x4_t x4 = xw[ai][m][bj];
                    const f32x4 v0 = bf16lo4(x4.x, x4.y) * ALPHA_ + acc[ai][bj][m][0], v1 = bf16lo4(x4.z, x4.w) * ALPHA_ + acc[ai][bj][m][1];
                    *(u32x4_t*)(Y + ro + bj * HALF) = pack8(v0, v1); } }
    }
};
struct EpiGU {
    static constexpr int ID = 64; static constexpr bool PERM = true, AFTER_DRAIN = false;
    bf16_t* O;
    __device__ __forceinline__ void operator()(const f32x4 (&acc)[2][2][4][2], const Unit& u, int wr, int wc, int fr, int fq) const {
        const int row0 = u.pm * BM + wr * 64 + fr, col0 = u.pn * HALF + wc * 32 + 8 * fq;
#pragma unroll
        for (int ai = 0; ai < 2; ++ai)
#pragma unroll
            for (int m = 0; m < 4; ++m) { f32x4 h0, h1;
#pragma unroll
                for (int j = 0; j < 4; ++j) { const float g0 = acc[ai][0][m][0][j], g1 = acc[ai][0][m][1][j];
                    h0[j] = g0 * __builtin_amdgcn_rcpf(1.0f + __builtin_amdgcn_exp2f(-g0 * LOG2E_)) * acc[ai][1][m][0][j];
                    h1[j] = g1 * __builtin_amdgcn_rcpf(1.0f + __builtin_amdgcn_exp2f(-g1 * LOG2E_)) * acc[ai][1][m][1][j]; }
                *(u32x4_t*)(O + (size_t)(row0 + ai * HALF + m * 16) * FF_ + col0) = pack8(h0, h1); }
    }
};


template <class Epi, class Sched, bool ALIGN_EPI = false, bool SP2 = false>
__device__ __forceinline__ void gemm_phase(PG8_LAS unsigned char* lds, const Gemm g, const Sched& S, const Epi& E) {
    const int tid = fresh_tid(), wid = __builtin_amdgcn_readfirstlane(tid >> 6), lane = tid & 63, wr = wid >> 2, wc = wid & 3, fr = lane & 15, fq = lane >> 4;
    const int K = g.K, nt = K / BK;
    unsigned voffA[2], voffB[2];
#pragma unroll
    for (int i = 0; i < 2; ++i) { int R, C; stage_rc(tid * 16 + i * 8192, R, C); const int Rb = Epi::PERM ? ((R & ~31) + perm32(R & 31)) : R;
        voffA[i] = (unsigned)(R * K + C) * 2u; voffB[i] = (unsigned)(Rb * K + C) * 2u; }
    const size_t kstep = (size_t)(BK * 2);
    const size_t hstep = (size_t)HALF * K * 2;
    const size_t tstep = 2 * hstep;
    const unsigned ldsw = (unsigned)wid * 1024u;
    const int aoff = lds_byte(wr * 64 + fr, fq * 8), boff = lds_byte(wc * 32 + fr, fq * 8);
#define PG8_SA(b, h) (((b) * 2 + (h)) * HTB)
#define PG8_SB(b, h) ((4 + (b) * 2 + (h)) * HTB)
#define PG8_STAGE(bufoff, gbase, voff) do { _Pragma("unroll") for (int _i = 0; _i < 2; ++_i) \
        __builtin_amdgcn_global_load_lds((const unsigned*)((const char*)(gbase) + (voff)[_i]), (PG8_LAS unsigned*)(lds + (bufoff) + ldsw + _i * 8192), 16, 0, 0); } while (0)
#define PG8_LDA(dst, b, h) do { _Pragma("unroll") for (int m = 0; m < 4; ++m) _Pragma("unroll") for (int k = 0; k < 2; ++k) dst[m][k] = *(const PG8_LAS bf16x8*)(lds + PG8_SA(b, h) + aoff + m * 2048 + k * 1024); } while (0)
#define PG8_LDB(dst, b, h) do { _Pragma("unroll") for (int n = 0; n < 2; ++n) _Pragma("unroll") for (int k = 0; k < 2; ++k) dst[n][k] = *(const PG8_LAS bf16x8*)(lds + PG8_SB(b, h) + boff + n * 2048 + k * 1024); } while (0)
#define PG8_MMA(ai, bj, At, Bt) do { __builtin_amdgcn_s_setprio(1); _Pragma("unroll") for (int m = 0; m < 4; ++m) _Pragma("unroll") for (int n = 0; n < 2; ++n) _Pragma("unroll") for (int k = 0; k < 2; ++k) \
        acc[ai][bj][m][n] = __builtin_amdgcn_mfma_f32_16x16x32_bf16(Bt[n][k], At[m][k], acc[ai][bj][m][n], 0, 0, 0); __builtin_amdgcn_s_setprio(0); } while (0)
#define PG8_WAIT_V(n) asm volatile("s_waitcnt vmcnt(" #n ")" ::: "memory")
#define PG8_WAIT_L(n) asm volatile("s_waitcnt lgkmcnt(" #n ")" ::: "memory")
#define PG8_BAR __builtin_amdgcn_s_barrier()
#define PG8_SCHED __builtin_amdgcn_sched_barrier(0)
    Unit cur, nxt; int ui = 0;
    if (!S.next(0, cur)) return;
    f32x4 acc[2][2][4][2];
#pragma unroll
    for (int a = 0; a < 2; ++a)
#pragma unroll
        for (int b = 0; b < 2; ++b)
#pragma unroll
            for (int m = 0; m < 4; ++m)
#pragma unroll
                for (int n = 0; n < 2; ++n) acc[a][b][m][n] = (f32x4){0.f, 0.f, 0.f, 0.f};
    bf16x8 At[4][2], B0[2][2], B1[2][2];
    const char* cA = (const char*)g.A + (size_t)cur.pm * tstep; const char* cB = (const char*)g.Bt + (size_t)cur.pn * tstep;
    S.a_ready(cur);
    if constexpr (SP2) {
        PG8_STAGE(PG8_SB(0, 0), cB, voffB); PG8_STAGE(PG8_SB(0, 1), cB + hstep, voffB); PG8_STAGE(PG8_SA(0, 0), cA, voffA); PG8_STAGE(PG8_SA(0, 1), cA + hstep, voffA);
        if (wr == 1) PG8_BAR;
        PG8_WAIT_V(2); PG8_BAR;
        PG8_STAGE(PG8_SB(1, 0), cB + kstep, voffB); PG8_STAGE(PG8_SA(1, 0), cA + kstep, voffA); PG8_STAGE(PG8_SB(1, 1), cB + hstep + kstep, voffB);
        PG8_WAIT_V(6); PG8_BAR;
    } else {
        PG8_STAGE(PG8_SB(0, 0), cB, voffB); PG8_STAGE(PG8_SA(0, 0), cA, voffA); PG8_STAGE(PG8_SB(0, 1), cB + hstep, voffB); PG8_STAGE(PG8_SA(0, 1), cA + hstep, voffA);
        if (wr == 1) PG8_BAR;
        PG8_WAIT_V(4); PG8_BAR;
        PG8_STAGE(PG8_SB(1, 0), cB + kstep, voffB); PG8_STAGE(PG8_SA(1, 0), cA + kstep, voffA); PG8_STAGE(PG8_SB(1, 1), cB + hstep + kstep, voffB);
        PG8_WAIT_V(6); PG8_BAR;
    }
    for (;;) {
        const bool has_next = S.next(ui + 1, nxt);
        const char* nA = has_next ? (const char*)g.A + (size_t)nxt.pm * tstep : cA; const char* nB = has_next ? (const char*)g.Bt + (size_t)nxt.pn * tstep : cB;
        for (int t = 0; t < nt; t += 2) {
            const bool last = (t == nt - 2);
            const char* a1 = cA + (size_t)(t + 1) * kstep;
            const char* a2 = last ? nA : cA + (size_t)(t + 2) * kstep; const char* b2 = last ? nB : cB + (size_t)(t + 2) * kstep;
            const char* a3 = a2 + kstep; const char* b3 = b2 + kstep;
            if (last && has_next) S.a_ready(nxt);
            if constexpr (SP2) {
            PG8_LDB(B0, 0, 0); PG8_LDB(B1, 0, 1); PG8_SCHED; PG8_LDA(At, 0, 0); PG8_STAGE(PG8_SA(1, 1), a1 + hstep, voffA);
            PG8_WAIT_V(8); PG8_WAIT_L(0); PG8_BAR; PG8_MMA(0, 0, At, B0); PG8_MMA(0, 1, At, B1); PG8_BAR; PG8_SCHED;
            PG8_LDA(At, 0, 1); PG8_STAGE(PG8_SB(0, 0), b2, voffB); PG8_STAGE(PG8_SB(0, 1), b2 + hstep, voffB); PG8_STAGE(PG8_SA(0, 0), a2, voffA);
            PG8_WAIT_V(8); PG8_WAIT_L(0); PG8_BAR; PG8_MMA(1, 0, At, B0); PG8_MMA(1, 1, At, B1); PG8_BAR; PG8_SCHED;
            PG8_LDB(B0, 1, 0); PG8_LDB(B1, 1, 1); PG8_SCHED; PG8_LDA(At, 1, 0); PG8_STAGE(PG8_SA(0, 1), a2 + hstep, voffA);
            PG8_WAIT_V(8); PG8_WAIT_L(0); PG8_BAR; PG8_MMA(0, 0, At, B0); PG8_MMA(0, 1, At, B1); PG8_BAR; PG8_SCHED;
            PG8_LDA(At, 1, 1); PG8_STAGE(PG8_SB(1, 0), b3, voffB); PG8_STAGE(PG8_SB(1, 1), b3 + hstep, voffB); PG8_STAGE(PG8_SA(1, 0), a3, voffA);
            PG8_WAIT_V(8); PG8_WAIT_L(0); PG8_BAR; PG8_MMA(1, 0, At, B0); PG8_MMA(1, 1, At, B1); PG8_BAR; PG8_SCHED;
            } else {
            PG8_LDB(B0, 0, 0); PG8_SCHED; PG8_LDA(At, 0, 0); PG8_STAGE(PG8_SA(1, 1), a1 + hstep, voffA);
            PG8_WAIT_L(8); PG8_BAR; PG8_WAIT_L(0); PG8_MMA(0, 0, At, B0); PG8_BAR; PG8_SCHED;
            PG8_LDB(B1, 0, 1); PG8_STAGE(PG8_SB(0, 0), b2, voffB);
            PG8_BAR; PG8_WAIT_L(0); PG8_MMA(0, 1, At, B1); PG8_BAR;
            PG8_LDA(At, 0, 1); PG8_STAGE(PG8_SA(0, 0), a2, voffA);
            PG8_BAR; PG8_WAIT_L(0); PG8_MMA(1, 0, At, B0); PG8_BAR; PG8_SCHED;
            PG8_STAGE(PG8_SB(0, 1), b2 + hstep, voffB);
            PG8_WAIT_V(6); PG8_BAR; PG8_MMA(1, 1, At, B1); PG8_BAR;
            PG8_LDB(B0, 1, 0); PG8_SCHED; PG8_LDA(At, 1, 0); PG8_STAGE(PG8_SA(0, 1), a2 + hstep, voffA);
            PG8_WAIT_L(8); PG8_BAR; PG8_WAIT_L(0); PG8_MMA(0, 0, At, B0); PG8_BAR; PG8_SCHED;
            PG8_LDB(B1, 1, 1); PG8_STAGE(PG8_SB(1, 0), b3, voffB);
            PG8_BAR; PG8_WAIT_L(0); PG8_MMA(0, 1, At, B1); PG8_BAR;
            PG8_LDA(At, 1, 1); PG8_STAGE(PG8_SA(1, 0), a3, voffA);
            PG8_BAR; PG8_WAIT_L(0); PG8_MMA(1, 0, At, B0); PG8_BAR; PG8_SCHED;
            PG8_STAGE(PG8_SB(1, 1), b3 + hstep, voffB);
            PG8_WAIT_V(6); PG8_BAR; PG8_MMA(1, 1, At, B1); PG8_BAR;
            }
        }
        if constexpr (ALIGN_EPI) { if (wr == 0) PG8_BAR; }
        if constexpr (!Epi::AFTER_DRAIN) { E(acc, cur, wr, wc, fr, fq); S.done(cur); }
        if (!has_next) break;
#pragma unroll
        for (int a = 0; a < 2; ++a)
#pragma unroll
            for (int b = 0; b < 2; ++b)
#pragma unroll
                for (int m = 0; m < 4; ++m)
#pragma unroll
                    for (int n = 0; n < 2; ++n) acc[a][b][m][n] = (f32x4){0.f, 0.f, 0.f, 0.f};
        cur = nxt; cA = nA; cB = nB; ++ui;
        if constexpr (ALIGN_EPI) { if (wr == 1) PG8_BAR; }
    }
    PG8_WAIT_V(0);
    if constexpr (!ALIGN_EPI) { if (wr == 0) PG8_BAR; }
    PG8_BAR;
    if constexpr (Epi::AFTER_DRAIN) { E.fused(acc, cur, wr, wc, fr, fq, lds, wid, lane); S.done(cur); }
#undef PG8_SA
#undef PG8_SB
#undef PG8_STAGE
#undef PG8_LDA
#undef PG8_LDB
#undef PG8_MMA
#undef PG8_WAIT_V
#undef PG8_WAIT_L
#undef PG8_BAR
#undef PG8_SCHED
}
}


using pg8::bf16_t; using pg8::bf16x8; using pg8::f32x4; using pg8::u32x4_t;
typedef float f32x16 __attribute__((ext_vector_type(16)));
typedef short s16x4 __attribute__((ext_vector_type(4)));
#define MFMA32(a, b, c) __builtin_amdgcn_mfma_f32_32x32x16_bf16((a), (b), (c), 0, 0, 0)

constexpr size_t OFF_WIN = 0;
constexpr size_t OFF_WVA = OFF_WIN + 4096ull * 2048 * 2;
constexpr size_t OFF_WUQ = OFF_WVA + 1024ull * 2048 * 2;
constexpr size_t OFF_WUKK = OFF_WUQ + 1536ull * 512 * 2;
constexpr size_t OFF_WUKV = OFF_WUKK + 1024ull * 256 * 2;
constexpr size_t OFF_WO = OFF_WUKV + 1024ull * 256 * 2;
constexpr size_t OFF_RT = OFF_WO + 2048ull * 2048 * 2;
constexpr size_t OFF_MASK = OFF_RT + (size_t)T_ * RTW_ * 4;
constexpr size_t OFF_KNOPE = OFF_MASK + (size_t)T_ * 128 * 4;
constexpr size_t OFF_VTB = OFF_KNOPE + (size_t)T_ * 1024 * 2;
constexpr size_t OFF_WGU = OFF_VTB + (size_t)T_ * 1024 * 2;
constexpr size_t OFF_WDN = OFF_WGU + 11264ull * 2048 * 2;
constexpr size_t OFF_XB = OFF_WDN + 2048ull * 5632 * 2;
constexpr size_t OFF_QA = OFF_XB + (size_t)T_ * 2048 * 2;
constexpr size_t OFF_KA = OFF_QA + (size_t)T_ * 1024 * 2;
constexpr size_t OFF_QI = OFF_KA + (size_t)T_ * 1024 * 2;
constexpr size_t OFF_VTA = OFF_QI + (size_t)T_ * 1024 * 2;
constexpr size_t OFF_CQ = OFF_VTA + (size_t)T_ * 1024 * 2;
constexpr size_t OFF_CKV = OFF_CQ + (size_t)T_ * 512 * 2;
constexpr size_t OFF_KI = OFF_CKV + (size_t)T_ * 256 * 2;
constexpr size_t OFF_KR = OFF_KI + (size_t)T_ * 64 * 2;
constexpr size_t OFF_WI = OFF_KR + (size_t)T_ * 64 * 2;
constexpr size_t OFF_RSQ = OFF_WI + (size_t)T_ * 16 * 4;
constexpr size_t OFF_RSKV = OFF_RSQ + (size_t)T_ * 8 * 4;
constexpr size_t OFF_QM = OFF_RSKV + (size_t)T_ * 4 * 4;
constexpr size_t WS_END = OFF_QM + (size_t)T_ * 1536 * 2;
constexpr size_t OFF_AO = WS_END;
constexpr size_t OFF_BAR = OFF_AO + (size_t)T_ * 2048 * 2;
static_assert(OFF_BAR + 16384 <= 536870912ull, "workspace");
static_assert(WS_END - OFF_QA >= (size_t)T_ * 5632 * 2, "h");

struct Params {
    const float* x; const int* pos; const float *w_in, *g_cq, *g_ckv, *w_uq, *w_ukv, *w_o, *ln1_g, *ln1_b, *w_gate, *w_up, *w_down, *ln2_g, *ln2_b;
    float* out; unsigned char* ws;
};

__device__ __forceinline__ int ropeA(int w) { if (w >= 32) return w; const int g = w >> 3, e = w & 7; return e < 4 ? 4 * g + e : 16 + 4 * g + (e - 4); }
__device__ __forceinline__ int ropeI(int w) { if (w >= 16) return w; const int g = w >> 3, e = w & 7; return e < 4 ? 4 * g + e : 8 + 4 * g + (e - 4); }
__device__ __forceinline__ int ropeM(int p) { const int g = p >> 3, e = p & 7; return e < 4 ? 4 * g + e : 32 + 4 * g + (e - 4); }
struct MapInMain { const float* w; __device__ __forceinline__ const float* operator()(int n) const {
    const int tile = n >> 8, c = n & 255; int src;
    if (tile < 8) { const int col = (tile & 3) * 256 + c, head = col >> 7, wd = col & 127; src = (tile < 4 ? 0 : 1024) + head * 128 + ropeA(wd); }
    else if (tile < 12) { const int col = (tile - 8) * 256 + c, head = col >> 6, wd = col & 63; src = 3072 + head * 64 + ropeI(wd); }
    else if (tile < 14) src = 4176 + (tile - 12) * 256 + c;
    else if (tile == 14) src = 4688 + c;
    else { if (c < 64) src = 4112 + ropeI(c); else if (c < 128) src = 4944 + ropeM(c - 64); else if (c < 144) src = 4096 + (c - 128); else return nullptr; }
    return w + src; } };
struct MapOff { const float* w; __device__ __forceinline__ const float* operator()(int n) const { return w + n; } };
struct MapUq { const float* w; __device__ __forceinline__ const float* operator()(int n) const { const int head = n / 192, wd = n % 192; return w + head * 192 + (wd < 128 ? wd : 128 + ropeM(wd - 128)); } };
struct MapUkv { const float* w; __device__ __forceinline__ const float* operator()(int n) const { return w + (n >> 7) * 256 + (n & 127); } };
struct MapGU { const float *g, *u; __device__ __forceinline__ const float* operator()(int n) const { const int tile = n >> 8, c = n & 255; return c < 128 ? g + tile * 128 + c : u + tile * 128 + (c - 128); } };

template <class Map>
__device__ __forceinline__ void conv_job(unsigned char* lds, const Map map, int ldsrc, int K, int Nd, bf16_t* dst, const float* gain, int& base) {
    const int tid = fresh_tid(), G = gridDim.x; unsigned short* tile = (unsigned short*)lds;
    const int nkt = K / 64, ntiles = (Nd / 64) * nkt, nn = tid & 63, kq = tid >> 6;
    const int first = ((int)blockIdx.x - base % G + G) % G;
    float v[8], vn[8];
#define CONV_LOAD(dst_, i_) do { const int n0_ = ((i_) / nkt) * 64, k0_ = ((i_) % nkt) * 64; const float* cp_ = map(n0_ + nn); \
        _Pragma("unroll") for (int r = 0; r < 8; ++r) { const int kk_ = r * 8 + kq; float x_ = cp_ ? cp_[(size_t)(k0_ + kk_) * ldsrc] : 0.f; if (gain) x_ *= gain[k0_ + kk_]; (dst_)[r] = x_; } } while (0)
    if (first < ntiles) CONV_LOAD(v, first);
    for (int i = first; i < ntiles; i += G) {
        const int n0 = (i / nkt) * 64, k0 = (i % nkt) * 64;
        if (i + G < ntiles) CONV_LOAD(vn, i + G);
#pragma unroll
        for (int r = 0; r < 8; ++r) tile[nn * 66 + r * 8 + kq] = (unsigned short)(pk2(v[r], 0.f) & 0xffffu);
        __syncthreads();
        { const int rn = tid >> 3, pc = tid & 7; const unsigned* s = (const unsigned*)(tile + rn * 66 + pc * 8); uint4 w; w.x = s[0]; w.y = s[1]; w.z = s[2]; w.w = s[3];
          *(uint4*)(dst + (size_t)(n0 + rn) * K + k0 + pc * 8) = w; }
        __syncthreads();
#pragma unroll
        for (int r = 0; r < 8; ++r) v[r] = vn[r];
    }
#undef CONV_LOAD
    base += ntiles;
}
__device__ __forceinline__ void conv_attn_weights(unsigned char* lds, const Params& p, int l) {
    int base = 0; unsigned char* ws = p.ws;
    const float* w_in = p.w_in + (size_t)l * DM_ * INC_;
    conv_job(lds, MapInMain{w_in}, INC_, DM_, 4096, (bf16_t*)(ws + OFF_WIN), nullptr, base);
    conv_job(lds, MapOff{w_in + 2048}, INC_, DM_, 1024, (bf16_t*)(ws + OFF_WVA), nullptr, base);
    conv_job(lds, MapUq{p.w_uq + (size_t)l * 512 * 1536}, 1536, 512, 1536, (bf16_t*)(ws + OFF_WUQ), p.g_cq + l * 512, base);
    conv_job(lds, MapUkv{p.w_ukv + (size_t)l * 256 * 2048}, 2048, 256, 1024, (bf16_t*)(ws + OFF_WUKK), p.g_ckv + l * 256, base);
    conv_job(lds, MapUkv{p.w_ukv + (size_t)l * 256 * 2048 + 128}, 2048, 256, 1024, (bf16_t*)(ws + OFF_WUKV), p.g_ckv + l * 256, base);
    conv_job(lds, MapOff{p.w_o + (size_t)l * 2048 * 2048}, 2048, 2048, 2048, (bf16_t*)(ws + OFF_WO), nullptr, base);
}
__device__ __forceinline__ void conv_ffn_weights(unsigned char* lds, const Params& p, int l) {
    int base = 0; unsigned char* ws = p.ws;
    conv_job(lds, MapGU{p.w_gate + (size_t)l * DM_ * FF_, p.w_up + (size_t)l * DM_ * FF_}, FF_, DM_, 2 * FF_, (bf16_t*)(ws + OFF_WGU), nullptr, base);
    conv_job(lds, MapOff{p.w_down + (size_t)l * FF_ * DM_}, DM_, FF_, DM_, (bf16_t*)(ws + OFF_WDN), nullptr, base);
}
__device__ __forceinline__ void rope_table_job(const int* pos, float* rt) {
    const int tid = fresh_tid();
    for (int idx = blockIdx.x * 512 + tid; idx < T_ * 56; idx += gridDim.x * 512) {
        const int t = idx / 56, f = idx % 56; float theta, e;
        if (f < 16) { theta = 500000.0f; e = (-2.0f * (float)f) / 32.0f; } else if (f < 48) { theta = 10000.0f; e = (-2.0f * (float)(f - 16)) / 64.0f; } else { theta = 500000.0f; e = (-2.0f * (float)(f - 48)) / 16.0f; }
        const float inv = powf(theta, e), ang = (float)pos[t] * inv; float s, c; sincosf(ang, &s, &c);
        rt[(size_t)t * RTW_ + 2 * f] = c; rt[(size_t)t * RTW_ + 2 * f + 1] = s; }
}
__device__ __forceinline__ void x_to_bf16_job(const float* x, bf16_t* xb) {
    const int tid = fresh_tid();
    const size_t n = (size_t)T_ * DM_ / 8, step = (size_t)gridDim.x * 512;
    size_t i = (size_t)blockIdx.x * 512 + tid;
    for (; i + 3 * step < n; i += 4 * step) {
        f32x4 a[4], b[4];
#pragma unroll
        for (int u = 0; u < 4; ++u) { a[u] = *(const f32x4*)(x + (i + u * step) * 8); b[u] = *(const f32x4*)(x + (i + u * step) * 8 + 4); }
#pragma unroll
        for (int u = 0; u < 4; ++u) *(u32x4_t*)(xb + (i + u * step) * 8) = pg8::pack8(a[u], b[u]);
    }
    for (; i < n; i += step) { const f32x4 a = *(const f32x4*)(x + i * 8), b = *(const f32x4*)(x + i * 8 + 4); *(u32x4_t*)(xb + i * 8) = pg8::pack8(a, b); }
}
__device__ __forceinline__ float wave_sum(float v) {
#pragma unroll
    for (int o = 32; o >= 1; o >>= 1) v += __shfl_xor(v, o);
    return v; }
__device__ __forceinline__ void ln_job(const bf16_t* y, const float* g, const float* bta, bf16_t* xb, float* outf) {
    const int tid = fresh_tid(), wv = tid >> 6, lane = tid & 63, step = gridDim.x * 8;
    int row = blockIdx.x * 8 + wv;
    u32x4_t w[4], wn[4];
#pragma unroll
    for (int i = 0; i < 4; ++i) { w[i] = (u32x4_t){0u, 0u, 0u, 0u}; wn[i] = w[i]; }
    f32x4 gv[8], bv[8];
#pragma unroll
    for (int i = 0; i < 4; ++i) { const int c = 8 * lane + 512 * i; gv[2 * i] = *(const f32x4*)(g + c); gv[2 * i + 1] = *(const f32x4*)(g + c + 4); bv[2 * i] = *(const f32x4*)(bta + c); bv[2 * i + 1] = *(const f32x4*)(bta + c + 4); }
    if (row < T_) {
#pragma unroll
        for (int i = 0; i < 4; ++i) w[i] = *(const u32x4_t*)(y + (size_t)row * DM_ + 8 * lane + 512 * i); }
    for (; row < T_; row += step) {
        if (row + step < T_) {
#pragma unroll
            for (int i = 0; i < 4; ++i) wn[i] = *(const u32x4_t*)(y + (size_t)(row + step) * DM_ + 8 * lane + 512 * i); }
        f32x4 v[8]; float s = 0.f;
#pragma unroll
        for (int i = 0; i < 4; ++i) { v[2 * i] = pg8::bf16lo4(w[i].x, w[i].y); v[2 * i + 1] = pg8::bf16lo4(w[i].z, w[i].w); }
#pragma unroll
        for (int i = 0; i < 8; ++i) s += (v[i][0] + v[i][1]) + (v[i][2] + v[i][3]);
        const float mu = wave_sum(s) * (1.0f / DM_); float q = 0.f;
#pragma unroll
        for (int i = 0; i < 8; ++i) { v[i] -= mu; q += (v[i][0] * v[i][0] + v[i][1] * v[i][1]) + (v[i][2] * v[i][2] + v[i][3] * v[i][3]); }
        const float rstd = 1.0f / sqrtf(wave_sum(q) * (1.0f / DM_) + 1e-5f);
#pragma unroll
        for (int i = 0; i < 4; ++i) { const int c = 8 * lane + 512 * i;
            const f32x4 o0 = v[2 * i] * rstd * gv[2 * i] + bv[2 * i], o1 = v[2 * i + 1] * rstd * gv[2 * i + 1] + bv[2 * i + 1];
            if (xb) *(u32x4_t*)(xb + (size_t)row * DM_ + c) = pg8::pack8(o0, o1);
            if (outf) { *(f32x4*)(outf + (size_t)row * DM_ + c) = o0; *(f32x4*)(outf + (size_t)row * DM_ + c + 4) = o1; } }
#pragma unroll
        for (int i = 0; i < 4; ++i) w[i] = wn[i];
    }
}
__device__ __forceinline__ unsigned f2key(float f) { const unsigned u = __float_as_uint(f); return (u & 0x80000000u) ? ~u : (u | 0x80000000u); }
template <int NR>
__device__ __forceinline__ unsigned long long topk_row(const float* sc, int q, int lane) {
    unsigned key[NR];
#pragma unroll
    for (int r = 0; r < NR; ++r) { const int pp = 64 * r + lane; const float f = __hip_atomic_load(sc + pp, __ATOMIC_RELAXED, __HIP_MEMORY_SCOPE_AGENT); key[r] = (pp <= q) ? f2key(f) : 0u; }
    unsigned lo = 0u, hi = 0xFFFFFFFFu;
    while (hi - lo > 1u) {
        const unsigned mid = lo + ((hi - lo) >> 1); int c = 0;
#pragma unroll
        for (int r = 0; r < NR; ++r) c += __popcll(__ballot(key[r] > mid));
        if (c > 256) lo = mid; else { hi = mid; if (c == 256) break; }
    }
    unsigned long long mine = 0ull;
#pragma unroll
    for (int r = 0; r < NR; ++r) { const unsigned long long bl = __ballot(key[r] > hi); if (lane == r) mine = bl; }
    return mine;
}
typedef float f32x4v __attribute__((ext_vector_type(4)));
#define MFMA16(a, b, c) __builtin_amdgcn_mfma_f32_16x16x32_bf16((a), (b), (c), 0, 0, 0)
__device__ __forceinline__ float relu1(float x) { const int i = __float_as_int(x); return __int_as_float(i > 0 ? i : 0); }
__device__ __forceinline__ float key2f(unsigned k) { return __uint_as_float((k & 0x80000000u) ? (k & 0x7fffffffu) : ~k); }
__device__ __forceinline__ float zscore_of_count(float c, float rn) {
    const float p = c * rn, q = fmaxf(p > 0.5f ? 1.0f - p : p, 1e-7f);
    const float tt = sqrtf(-1.3862943611f * __builtin_amdgcn_logf(q));
    const float zz = tt - (2.30753f + 0.27061f * tt) * __builtin_amdgcn_rcpf(1.0f + tt * (0.99229f + 0.04481f * tt));
    return p > 0.5f ? -zz : zz; }
__device__ __forceinline__ void indexer_job(unsigned char* lds, const bf16_t* qi, const bf16_t* ki, const float* wi, unsigned* mask) {
    for (int pr = blockIdx.x; pr < 256; pr += gridDim.x) {
        const int b = pr >> 6, ip = pr & 63;
        uint4 pfq[4]; float pfw = 0.f;
#pragma unroll
        for (int r = 0; r < 4; ++r) pfq[r] = make_uint4(0u, 0u, 0u, 0u);
#pragma unroll 1
        for (int w4 = 0; w4 < 4; ++w4) {
            const int qb = (w4 == 0) ? ip : (w4 == 1) ? 255 - ip : (w4 == 2) ? 127 - ip : 128 + ip;
            const int q0 = qb * 16; const size_t tok0 = (size_t)b * S_ + q0;
            {
                const int tid = fresh_tid();
                unsigned char* dst0 = lds + (tid >> 7) * 2064 + (tid & 127) * 16;
                if (w4 == 0) { const unsigned char* src0 = (const unsigned char*)(qi + tok0 * 1024) + (tid >> 7) * 2048 + (tid & 127) * 16;
#pragma unroll
                    for (int r = 0; r < 4; ++r) pfq[r] = *(const uint4*)(src0 + r * 4 * 2048);
                    pfw = tid < 256 ? wi[(tok0 + (tid >> 4)) * 16 + (tid & 15)] : 0.f; }
#pragma unroll
                for (int r = 0; r < 4; ++r) *(uint4*)(dst0 + r * 4 * 2064) = pfq[r];
                if (tid < 256) { const int qq = tid >> 4, hh = tid & 15; ((float*)(lds + 33024))[hh * 16 + qq] = pfw; }
            }
            __syncthreads();
            const int tid = fresh_tid(), wv = tid >> 6, lane = tid & 63, qq = lane & 15, grp = lane >> 4;
            const int qpos = q0 + qq;
            unsigned key[128];
            {
                const unsigned char* qrow = lds + qq * 2064 + grp * 16; const float* wl = (const float*)(lds + 33024) + qq;
                const unsigned char* kbase = (const unsigned char*)(ki + ((size_t)b * S_ + qq) * 64) + grp * 16;
#define IDX_LDQ(q0_, q1_, w_, h_) do { (q0_) = *(const bf16x8*)(qrow + (h_) * 128); (q1_) = *(const bf16x8*)(qrow + (h_) * 128 + 64); (w_) = wl[(h_) * 16]; } while (0)
#define IDX_MM(X_, q0_, q1_) do { _Pragma("unroll") for (int i = 0; i < 2; ++i) (X_)[i] = MFMA16(kf[i][0], (q0_), ((f32x4v){0.f, 0.f, 0.f, 0.f})); \
                                  _Pragma("unroll") for (int i = 0; i < 2; ++i) (X_)[i] = MFMA16(kf[i][1], (q1_), (X_)[i]); } while (0)
#define IDX_ACC(X_, w_) do { _Pragma("unroll") for (int i = 0; i < 2; ++i) _Pragma("unroll") for (int j = 0; j < 4; ++j) sacc[i][j] += (w_) * relu1((X_)[i][j]); } while (0)
#define IDX_LOADKF(dst_, tp_) do { const int kt0_ = wv + 16 * (tp_); _Pragma("unroll") for (int i = 0; i < 2; ++i) { const int kti = kt0_ + 8 * i, ktc = kti <= qb ? kti : kt0_; \
                    (dst_)[i][0] = *(const bf16x8*)(kbase + (size_t)ktc * 2048); (dst_)[i][1] = *(const bf16x8*)(kbase + (size_t)ktc * 2048 + 64); } } while (0)
                bf16x8 kf[2][2], kfn[2][2];
#pragma unroll
                for (int i = 0; i < 2; ++i) { kf[i][0] = (bf16x8){0, 0, 0, 0, 0, 0, 0, 0}; kf[i][1] = kf[i][0]; kfn[i][0] = kf[i][0]; kfn[i][1] = kf[i][0]; }
                if (wv <= qb) IDX_LOADKF(kf, 0);
#pragma unroll
                for (int tp = 0; tp < 16; ++tp) {
                    const int kt0 = wv + 16 * tp;
                    if (tp + 1 < 16 && kt0 + 16 <= qb) IDX_LOADKF(kfn, tp + 1);
                    if (kt0 <= qb) {
                        f32x4v sacc[2];
#pragma unroll
                        for (int i = 0; i < 2; ++i) sacc[i] = (f32x4v){0.f, 0.f, 0.f, 0.f};
                        {
                        f32x4v accA[2], accB[2]; bf16x8 qx0, qx1, qy0, qy1; float wA, wB, wx, wy;
                        IDX_LDQ(qy0, qy1, wA, 0); IDX_LDQ(qx0, qx1, wx, 1);
                        IDX_MM(accA, qy0, qy1);
#pragma unroll 1
                        for (int hh = 0; hh < 7; ++hh) {
                            IDX_LDQ(qy0, qy1, wy, 2 * hh + 2);
                            __builtin_amdgcn_sched_barrier(0);
                            IDX_MM(accB, qx0, qx1); wB = wx;
                            IDX_ACC(accA, wA);
                            __builtin_amdgcn_sched_barrier(0);
                            IDX_LDQ(qx0, qx1, wx, 2 * hh + 3);
                            __builtin_amdgcn_sched_barrier(0);
                            IDX_MM(accA, qy0, qy1); wA = wy;
                            IDX_ACC(accB, wB);
                            __builtin_amdgcn_sched_barrier(0);
                        }
                        IDX_MM(accB, qx0, qx1);
                        IDX_ACC(accA, wA);
                        IDX_ACC(accB, wx);
                        }
#pragma unroll
                        for (int i = 0; i < 2; ++i)
#pragma unroll
                            for (int j = 0; j < 4; ++j) { const int kp = 16 * (kt0 + 8 * i) + 4 * grp + j;
                                key[8 * tp + 4 * i + j] = (kt0 + 8 * i <= qb && kp <= qpos) ? f2key(sacc[i][j]) : 0u; }
                    } else {
#pragma unroll
                        for (int j = 0; j < 8; ++j) key[8 * tp + j] = 0u;
                    }
#pragma unroll
                    for (int i = 0; i < 2; ++i) { kf[i][0] = kfn[i][0]; kf[i][1] = kfn[i][1]; }
                }
#undef IDX_LOADKF
#undef IDX_LDQ
#undef IDX_MM
#undef IDX_ACC
            }
            if (w4 < 3) {
                const int qbn = (w4 == 0) ? 255 - ip : (w4 == 1) ? 127 - ip : 128 + ip; const size_t tokn = (size_t)b * S_ + qbn * 16;
                const unsigned char* srcn = (const unsigned char*)(qi + tokn * 1024) + (tid >> 7) * 2048 + (tid & 127) * 16;
#pragma unroll
                for (int r = 0; r < 4; ++r) pfq[r] = *(const uint4*)(srcn + r * 4 * 2048);
                pfw = tid < 256 ? wi[(tokn + (tid >> 4)) * 16 + (tid & 15)] : 0.f; }
            {
                unsigned* cb = (unsigned*)(lds + 34048);
                unsigned kmax = 0u, kmin1 = 0xFFFFFFFFu;
#pragma unroll
                for (int r = 0; r < 128; ++r) { kmax = key[r] > kmax ? key[r] : kmax; const unsigned k1 = key[r] - 1u; kmin1 = k1 < kmin1 ? k1 : kmin1; }
                { unsigned a = __shfl_xor(kmax, 16); kmax = a > kmax ? a : kmax; a = __shfl_xor(kmax, 32); kmax = a > kmax ? a : kmax;
                  unsigned c = __shfl_xor(kmin1, 16); kmin1 = c < kmin1 ? c : kmin1; c = __shfl_xor(kmin1, 32); kmin1 = c < kmin1 ? c : kmin1; }
                if (lane < 16) { cb[256 + wv * 16 + lane] = kmax; cb[384 + wv * 16 + lane] = kmin1; }
                __syncthreads();
#pragma unroll
                for (int w = 0; w < 8; ++w) { const unsigned a = cb[256 + w * 16 + qq], c = cb[384 + w * 16 + qq]; kmax = a > kmax ? a : kmax; kmin1 = c < kmin1 ? c : kmin1; }
                unsigned lo = kmin1, hi = kmax; bool done = false; int it = 0, side = 0;
                unsigned cntlo = (unsigned)(qpos + 1), cnthi = 0u;
                const float rn = __builtin_amdgcn_rcpf((float)(qpos + 1)), zt = zscore_of_count(256.0f, rn);
                float glo = zt - zscore_of_count((float)(qpos + 1) - 0.5f, rn), ghi = zt - zscore_of_count(0.5f, rn);
                if (qpos < 256) { hi = 0u; done = true; }
                while (!__all(done)) {
                    unsigned mid = lo + ((hi - lo) >> 1);
                    { const float flo = key2f(lo), fhi = key2f(hi); const unsigned dd = cntlo - cnthi;
                      const float fr = dd <= 200u ? (float)(cntlo - 256u) * __builtin_amdgcn_rcpf((float)dd) : glo / (glo - ghi);
                      const float xf = flo + (fhi - flo) * fr;
                      const unsigned kx = f2key(xf); if (kx > lo && kx < hi && (it & 15) != 15) mid = kx; }
                    unsigned c = 0u;
#pragma unroll
                    for (int r = 0; r < 128; ++r) c += (key[r] > mid) ? 1u : 0u;
                    c += __shfl_xor(c, 16); c += __shfl_xor(c, 32);
                    unsigned* cbi = cb + (it & 1) * 128;
                    if (lane < 16) cbi[wv * 16 + lane] = c;
                    __syncthreads();
                    unsigned tot = 0u;
#pragma unroll
                    for (int w = 0; w < 8; ++w) tot += cbi[w * 16 + qq];
                    if (!done) { const float g = zt - zscore_of_count(tot > 0u ? (float)tot : 0.5f, rn);
                        if (tot > 256u) { lo = mid; glo = g; cntlo = tot; if (side == 1) ghi *= 0.5f; side = 1; }
                        else { hi = mid; ghi = g; cnthi = tot; if (side == 2) glo *= 0.5f; side = 2; if (tot == 256u) done = true; }
                        if (hi - lo <= 1u) done = true; }
                    ++it;
                }
                unsigned short* mrow = (unsigned short*)(mask + (tok0 + qq) * 128);
#pragma unroll
                for (int t = 0; t < 32; ++t) { unsigned v = 0u;
#pragma unroll
                    for (int j = 0; j < 4; ++j) v |= (key[4 * t + j] > hi) ? (1u << j) : 0u;
                    v <<= 4 * grp; v |= __shfl_xor(v, 16); v |= __shfl_xor(v, 32);
                    if (lane < 16) mrow[wv + 8 * t] = (unsigned short)v; }
            }
            __syncthreads();
        }
    }
}
template <int DQK, bool MASKED>
__device__ __forceinline__ void attn_qblock(unsigned char* lds, const bf16_t* Qh, int ldq, const bf16_t* Kh, int ldk, const bf16_t* Kpe, const bf16_t* Vth, const unsigned* mask, bf16_t* outh, int b, int q0) {
    constexpr int NKK = DQK / 16, PPR = DQK / 8, NPK = 64 * PPR / 512, KSTR = DQK * 2 + 16, VSTR = 136, KBUF = 64 * KSTR, VBUF = 128 * VSTR, VOFF = 2 * KBUF;
    const int tid = fresh_tid(), wv = tid >> 6, lane = tid & 63, ql = lane & 31, half = lane >> 5;
    const int qpos = q0 + 32 * wv + ql; const size_t tq = (size_t)b * S_ + qpos;
    const bool late = wv >= 4;
    bf16x8 qf[NKK];
#pragma unroll
    for (int kk = 0; kk < NKK; ++kk) qf[kk] = *(const bf16x8*)(Qh + tq * ldq + 16 * kk + 8 * half);
    f32x16 o[4];
#pragma unroll
    for (int dt = 0; dt < 4; ++dt)
#pragma unroll
        for (int e = 0; e < 16; ++e) o[dt][e] = 0.f;
    float m = -1e30f, l = 0.f;
    const int ntiles = (q0 + 256) / 64;
    bf16x8 pb0, pb1, pb2, pb3;
#pragma unroll
    for (int j = 0; j < 8; ++j) { pb0[j] = 0; pb1[j] = 0; pb2[j] = 0; pb3[j] = 0; }
    uint4 kreg0, kreg1, kreg2, vreg0, vreg1; kreg2.x = kreg2.y = kreg2.z = kreg2.w = 0u;
#define ATT_KSRC(r_, it_) ({ const int pp_ = tid + 512 * (r_), row_ = pp_ / PPR, pc_ = pp_ % PPR; const size_t tok_ = (size_t)b * S_ + (it_) * 64 + row_; \
        (const uint4*)((pc_ < 16) ? Kh + tok_ * ldk + 8 * pc_ : Kpe + tok_ * 64 + 8 * (pc_ - 16)); })
#define ATT_VSRC(r_, it_) ({ const int pp_ = tid + 512 * (r_), row_ = pp_ >> 3, pc_ = pp_ & 7; (const uint4*)(Vth + (size_t)row_ * T_ + (size_t)b * S_ + (it_) * 64 + 8 * pc_); })
#define ATT_LOADG(it_) do { kreg0 = *ATT_KSRC(0, it_); kreg1 = *ATT_KSRC(1, it_); if (NPK == 3) kreg2 = *ATT_KSRC(2, it_); vreg0 = *ATT_VSRC(0, it_); vreg1 = *ATT_VSRC(1, it_); } while (0)
#define ATT_KDST(r_, base_) ({ const int pp_ = tid + 512 * (r_), row_ = pp_ / PPR, pc_ = pp_ % PPR; (uint4*)((base_) + row_ * KSTR + pc_ * 16); })
#define ATT_VST(r_, base_, v_) do { const int pp_ = tid + 512 * (r_), row_ = pp_ >> 3, pc_ = pp_ & 7; uint2 a_, b_; a_.x = (v_).x; a_.y = (v_).y; b_.x = (v_).z; b_.y = (v_).w; \
        *(uint2*)((base_) + row_ * VSTR + pc_ * 16) = a_; *(uint2*)((base_) + row_ * VSTR + pc_ * 16 + 8) = b_; } while (0)
#define ATT_STOREL(kb_, vb_) do { unsigned char* kbase_ = lds + (kb_) * KBUF; unsigned char* vbase_ = lds + VOFF + (vb_) * VBUF; *ATT_KDST(0, kbase_) = kreg0; *ATT_KDST(1, kbase_) = kreg1; if (NPK == 3) *ATT_KDST(2, kbase_) = kreg2; \
        ATT_VST(0, vbase_, vreg0); ATT_VST(1, vbase_, vreg1); } while (0)
#define ATT_QKSM(kb_, it_) do { const unsigned char* kb = lds + (kb_) * KBUF; const int s0 = (it_) * 64; \
        f32x16 st0, st1; \
        _Pragma("unroll") for (int e = 0; e < 16; ++e) { st0[e] = 0.f; st1[e] = 0.f; } \
        { const unsigned char* kp0 = kb + ql * KSTR + 16 * half; const unsigned char* kp1 = kp0 + 32 * KSTR; bf16x8 ka[2][4]; \
          ka[0][0] = *(const bf16x8*)(kp0); ka[0][1] = *(const bf16x8*)(kp1); ka[0][2] = *(const bf16x8*)(kp0 + 32); ka[0][3] = *(const bf16x8*)(kp1 + 32); \
          __builtin_amdgcn_sched_barrier(0); \
          _Pragma("unroll") for (int c = 0; c < NKK / 2; ++c) { \
            if (c + 1 < NKK / 2) { ka[(c + 1) & 1][0] = *(const bf16x8*)(kp0 + 64 * (c + 1)); ka[(c + 1) & 1][1] = *(const bf16x8*)(kp1 + 64 * (c + 1)); \
                                   ka[(c + 1) & 1][2] = *(const bf16x8*)(kp0 + 64 * (c + 1) + 32); ka[(c + 1) & 1][3] = *(const bf16x8*)(kp1 + 64 * (c + 1) + 32); } \
            __builtin_amdgcn_sched_barrier(0); \
            st0 = MFMA32(ka[c & 1][0], qf[2 * c], st0); st1 = MFMA32(ka[c & 1][1], qf[2 * c], st1); st0 = MFMA32(ka[c & 1][2], qf[2 * c + 1], st0); st1 = MFMA32(ka[c & 1][3], qf[2 * c + 1], st1); \
            __builtin_amdgcn_sched_barrier(0); } } \
        if (MASKED) { const uint2 mw = mwcur; const unsigned w0 = mw.x >> (4 * half), w1 = mw.y >> (4 * half); \
            _Pragma("unroll") for (int e = 0; e < 16; ++e) { const int bit = (e & 3) + 8 * (e >> 2); st0[e] = ((w0 >> bit) & 1u) ? st0[e] : -INFINITY; st1[e] = ((w1 >> bit) & 1u) ? st1[e] : -INFINITY; } \
        } else if (s0 + 63 > q0 + 32 * wv) { \
            _Pragma("unroll") for (int e = 0; e < 16; ++e) { const int key0 = s0 + (e & 3) + 8 * (e >> 2) + 4 * half; if (key0 > qpos) st0[e] = -INFINITY; if (key0 + 32 > qpos) st1[e] = -INFINITY; } \
        } \
        float mx = fmaxf(st0[0], st1[0]); \
        _Pragma("unroll") for (int e = 1; e < 16; ++e) mx = fmaxf(mx, fmaxf(st0[e], st1[e])); \
        mx = fmaxf(mx, __shfl_xor(mx, 32)); \
          \
        const bool keep = __all(mx - m <= 8.0f); float alpha = 1.0f; \
        if (!keep) { const float mnew = fmaxf(m, mx); alpha = __builtin_amdgcn_exp2f(m - mnew); m = mnew; } \
        float ps = 0.f; \
        _Pragma("unroll") for (int e = 0; e < 16; ++e) { st0[e] = __builtin_amdgcn_exp2f(st0[e] - m); st1[e] = __builtin_amdgcn_exp2f(st1[e] - m); ps += st0[e] + st1[e]; } \
        l = l * alpha + ps; \
        if (!keep) { \
            _Pragma("unroll") for (int dt = 0; dt < 4; ++dt) \
                _Pragma("unroll") for (int e = 0; e < 16; ++e) o[dt][e] *= alpha; } \
        { u32x4_t pw; \
          pw.x = pk2(st0[0], st0[1]); pw.y = pk2(st0[2], st0[3]); pw.z = pk2(st0[4], st0[5]); pw.w = pk2(st0[6], st0[7]); pb0 = __builtin_bit_cast(bf16x8, pw); \
          pw.x = pk2(st0[8], st0[9]); pw.y = pk2(st0[10], st0[11]); pw.z = pk2(st0[12], st0[13]); pw.w = pk2(st0[14], st0[15]); pb1 = __builtin_bit_cast(bf16x8, pw); \
          pw.x = pk2(st1[0], st1[1]); pw.y = pk2(st1[2], st1[3]); pw.z = pk2(st1[4], st1[5]); pw.w = pk2(st1[6], st1[7]); pb2 = __builtin_bit_cast(bf16x8, pw); \
          pw.x = pk2(st1[8], st1[9]); pw.y = pk2(st1[10], st1[11]); pw.z = pk2(st1[12], st1[13]); pw.w = pk2(st1[14], st1[15]); pb3 = __builtin_bit_cast(bf16x8, pw); } \
    } while (0)
#define ATT_LDV(dst_, vbp_, g_) do { _Pragma("unroll") for (int dt = 0; dt < 4; ++dt) { const unsigned char* vp = (vbp_) + (32 * dt + ql) * VSTR + (16 * (g_) + 4 * half) * 2; \
            const s16x4 lo = *(const s16x4*)vp, hi = *(const s16x4*)(vp + 16); (dst_)[dt] = __builtin_shufflevector(lo, hi, 0, 1, 2, 3, 4, 5, 6, 7); } } while (0)
#define ATT_MMV(src_, pb_) do { _Pragma("unroll") for (int dt = 0; dt < 4; ++dt) o[dt] = MFMA32((src_)[dt], (pb_), o[dt]); } while (0)
#define ATT_PV(vb_) do { const unsigned char* vbp = lds + VOFF + (vb_) * VBUF; bf16x8 va[2][4]; \
        ATT_LDV(va[0], vbp, 0); __builtin_amdgcn_sched_barrier(0); \
        ATT_LDV(va[1], vbp, 1); __builtin_amdgcn_sched_barrier(0); ATT_MMV(va[0], pb0); __builtin_amdgcn_sched_barrier(0); \
        ATT_LDV(va[0], vbp, 2); __builtin_amdgcn_sched_barrier(0); ATT_MMV(va[1], pb1); __builtin_amdgcn_sched_barrier(0); \
        ATT_LDV(va[1], vbp, 3); __builtin_amdgcn_sched_barrier(0); ATT_MMV(va[0], pb2); __builtin_amdgcn_sched_barrier(0); \
        ATT_MMV(va[1], pb3); __builtin_amdgcn_sched_barrier(0); } while (0)
    ATT_LOADG(0); ATT_STOREL(0, 0); if (ntiles > 1) ATT_LOADG(1);
    uint2 mwcur = make_uint2(0u, 0u), mwnext = make_uint2(0u, 0u);
    if (MASKED) mwcur = *(const uint2*)(mask + tq * 128);
    const int qmaxw = q0 + 32 * wv + 31;
    int vcur = 0, vprev = 2;
    for (int it = 0; it < ntiles; ++it) {
        const int vnext = vcur == 2 ? 0 : vcur + 1;
        __syncthreads();
        if (it + 1 < ntiles) { ATT_STOREL((it + 1) & 1, vnext); if (it + 2 < ntiles) ATT_LOADG(it + 2); }
        if (MASKED && it + 1 < ntiles) mwnext = *(const uint2*)(mask + tq * 128 + 2 * (it + 1));
        const bool vis = it * 64 <= qmaxw;
        if (!late) { if (vis) { ATT_QKSM(it & 1, it); ATT_PV(vcur); } }
        else { if (it > 0 && (it - 1) * 64 <= qmaxw) ATT_PV(vprev); if (vis) ATT_QKSM(it & 1, it); }
        vprev = vcur; vcur = vnext; mwcur = mwnext;
    }
    if (late && (ntiles - 1) * 64 <= qmaxw) ATT_PV(vprev);
    __syncthreads();
#undef ATT_LOADG
#undef ATT_STOREL
#undef ATT_KSRC
#undef ATT_VSRC
#undef ATT_KDST
#undef ATT_VST
#undef ATT_QKSM
#undef ATT_LDV
#undef ATT_MMV
#undef ATT_PV
    l += __shfl_xor(l, 32); const float inv = 1.0f / l;
#pragma unroll
    for (int dt = 0; dt < 4; ++dt)
#pragma unroll
        for (int g = 0; g < 4; ++g) { uint2 w; w.x = pk2(o[dt][4 * g] * inv, o[dt][4 * g + 1] * inv); w.y = pk2(o[dt][4 * g + 2] * inv, o[dt][4 * g + 3] * inv);
            *(uint2*)(outh + tq * 2048 + 32 * dt + 8 * g + 4 * half) = w; }
}
__device__ __forceinline__ void attn_job(unsigned char* lds, unsigned char* ws) {
    const bf16_t *qa = (const bf16_t*)(ws + OFF_QA), *ka = (const bf16_t*)(ws + OFF_KA), *vta = (const bf16_t*)(ws + OFF_VTA), *qm = (const bf16_t*)(ws + OFF_QM), *kn = (const bf16_t*)(ws + OFF_KNOPE),
                 *kr = (const bf16_t*)(ws + OFF_KR), *vtb = (const bf16_t*)(ws + OFF_VTB); const unsigned* mask = (const unsigned*)(ws + OFF_MASK); bf16_t* ao = (bf16_t*)(ws + OFF_AO);
    for (int u = blockIdx.x; u < 512; u += gridDim.x) {
        const int type = u >> 8, r0 = u & 255, r = (r0 & 7) * 32 + (r0 >> 3), bh = r >> 3, pair = r & 7, b = bh >> 3, h = bh & 7;
        if (type == 0) { for (int w2 = 0; w2 < 2; ++w2) attn_qblock<128, true>(lds, qa + h * 128, 1024, ka + h * 128, 1024, ka, vta + (size_t)h * 128 * T_, mask, ao + h * 128, b, (w2 ? pair : 15 - pair) * 256); }
        else { for (int w2 = 0; w2 < 2; ++w2) attn_qblock<192, false>(lds, qm + h * 192, 1536, kn + h * 128, 1024, kr, vtb + (size_t)h * 128 * T_, mask, ao + 1024 + h * 128, b, (w2 ? pair : 15 - pair) * 256); }
    }
}
#define XB_XCNT(j) (64 * (j))
#define XB_XSUB(j) (1024 + 64 * (j))
#define XB_XGEN(j) (2048 + 64 * (j))
#define XB_TOP 3072
#define XB_TOPGEN 3136
__device__ __forceinline__ unsigned xb_ld(unsigned* p) { return __hip_atomic_load(p, __ATOMIC_RELAXED, __HIP_MEMORY_SCOPE_AGENT); }
__device__ __forceinline__ unsigned xb_add(unsigned* p, unsigned v) { return __hip_atomic_fetch_add(p, v, __ATOMIC_RELAXED, __HIP_MEMORY_SCOPE_AGENT); }
__device__ __forceinline__ unsigned xb_xcc_id() { return (unsigned)__builtin_amdgcn_s_getreg((3 << 11) | 20) & 0xFu; }
__device__ __forceinline__ void grid_bar(unsigned* bar, unsigned x, unsigned nloc, unsigned nx, unsigned k) {
    asm volatile("s_waitcnt vmcnt(0)" ::: "memory");
    __syncthreads();
    if (threadIdx.x == 0) {
        const unsigned old = xb_add(&bar[XB_XSUB(x)], 1u);
        if (old + 1u == k * nloc) {
            __builtin_amdgcn_fence(__ATOMIC_RELEASE, "agent");
            asm volatile("s_waitcnt vmcnt(0)" ::: "memory");
            const unsigned og = xb_add(&bar[XB_TOP], 1u);
            if (og + 1u == k * nx) xb_add(&bar[XB_TOPGEN], 1u);
            else while (xb_ld(&bar[XB_TOPGEN]) < k) __builtin_amdgcn_s_sleep(1);
            __builtin_amdgcn_fence(__ATOMIC_ACQUIRE, "agent");
            xb_add(&bar[XB_XGEN(x)], 1u);
            asm volatile("s_waitcnt vmcnt(0)" ::: "memory");
        } else {
            while (xb_ld(&bar[XB_XGEN(x)]) < k) __builtin_amdgcn_s_sleep(1);
            __builtin_amdgcn_fence(__ATOMIC_ACQUIRE, "agent");
            asm volatile("s_waitcnt vmcnt(0)" ::: "memory");
        }
    }
    __syncthreads();
}
#ifndef GEMM_SEL
#define GEMM_SEL 127
#endif
#ifndef GEMM_ALIGN
#define GEMM_ALIGN true
#endif
#ifndef GEMM_SP2
#define GEMM_SP2 true
#endif
extern __shared__ __attribute__((aligned(16))) unsigned char dyn_lds[];
template <class Epi> __device__ __forceinline__ void run_gemm(const bf16_t* A, const bf16_t* Bt, int M, int N, int K, const Epi& E) {
    asm volatile("" : "+s"(M), "+s"(N), "+s"(K));
    pg8::Gemm g; g.A = A; g.Bt = Bt; g.M = M; g.N = N; g.K = K;
    pg8::StaticOrder S; S.init(M, N, (int)gridDim.x, (int)blockIdx.x);
#ifndef NO_GEMM
    if constexpr ((GEMM_SEL & Epi::ID) != 0) pg8::gemm_phase<Epi, pg8::StaticOrder, GEMM_ALIGN, GEMM_SP2>((PG8_LAS unsigned char*)dyn_lds, g, S, E);
#endif
}
__global__ void __launch_bounds__(512) mega(const Params p) {
    cg::grid_group grid = cg::this_grid();
    unsigned char* lds = dyn_lds; unsigned char* ws = p.ws;
    bf16_t* xb = (bf16_t*)(ws + OFF_XB); float* rt = (float*)(ws + OFF_RT);
    unsigned* barw = (unsigned*)(ws + OFF_BAR); const unsigned xcc = xb_xcc_id();
    if (threadIdx.x == 0) (void)xb_add(&barw[XB_XCNT(xcc)], 1u);
#ifndef NO_MISC
    rope_table_job(p.pos, rt);
    x_to_bf16_job(p.x, xb);
    conv_attn_weights(lds, p, 0);
#endif
    grid.sync();
    unsigned nbar = 0u, nloc = 1u, nxcd = 0u;
    for (unsigned j = 0; j < 16; ++j) { const unsigned c = xb_ld(&barw[XB_XCNT(j)]); nxcd += c > 0u ? 1u : 0u; nloc = (j == xcc) ? c : nloc; }
#pragma unroll 1
    for (int l = 0; l < 2; ++l) {
        {
            pg8::EpiInMain e; e.qa = (bf16_t*)(ws + OFF_QA); e.ka = (bf16_t*)(ws + OFF_KA); e.qi = (bf16_t*)(ws + OFF_QI); e.cq = (bf16_t*)(ws + OFF_CQ); e.ckv = (bf16_t*)(ws + OFF_CKV);
            e.ki = (bf16_t*)(ws + OFF_KI); e.kr = (bf16_t*)(ws + OFF_KR); e.wi = (float*)(ws + OFF_WI); e.rsq = (float*)(ws + OFF_RSQ); e.rskv = (float*)(ws + OFF_RSKV); e.rt = rt;
            run_gemm(xb, (const bf16_t*)(ws + OFF_WIN), T_, 4096, DM_, e);
            pg8::EpiPlainBf16 ev; ev.O = (bf16_t*)(ws + OFF_VTA); ev.ldc = T_;
            run_gemm((const bf16_t*)(ws + OFF_WVA), xb, 1024, T_, DM_, ev);
        }
        grid_bar(barw, xcc, nloc, nxcd, ++nbar);
        {
            pg8::EpiUq eq; eq.O = (bf16_t*)(ws + OFF_QM); eq.rsq = (const float*)(ws + OFF_RSQ); eq.rt = rt;
            run_gemm((const bf16_t*)(ws + OFF_CQ), (const bf16_t*)(ws + OFF_WUQ), T_, 1536, 512, eq);
            pg8::EpiUkvK ek; ek.O = (bf16_t*)(ws + OFF_KNOPE); ek.rskv = (const float*)(ws + OFF_RSKV);
            run_gemm((const bf16_t*)(ws + OFF_CKV), (const bf16_t*)(ws + OFF_WUKK), T_, 1024, 256, ek);
            pg8::EpiUkvV ev; ev.O = (bf16_t*)(ws + OFF_VTB); ev.rskv = (const float*)(ws + OFF_RSKV);
            run_gemm((const bf16_t*)(ws + OFF_WUKV), (const bf16_t*)(ws + OFF_CKV), 1024, T_, 256, ev);
#ifndef NO_IDX
            indexer_job(lds, (const bf16_t*)(ws + OFF_QI), (const bf16_t*)(ws + OFF_KI), (const float*)(ws + OFF_WI), (unsigned*)(ws + OFF_MASK));
#endif
        }
        grid_bar(barw, xcc, nloc, nxcd, ++nbar);
#ifndef NO_ATTN
        attn_job(lds, ws);
#endif
        grid_bar(barw, xcc, nloc, nxcd, ++nbar);
        {
            pg8::EpiResB e; e.Y = (bf16_t*)(ws + OFF_QA); e.X = xb;
            run_gemm((const bf16_t*)(ws + OFF_AO), (const bf16_t*)(ws + OFF_WO), T_, DM_, DM_, e);
        }
        grid_bar(barw, xcc, nloc, nxcd, ++nbar);
#ifndef NO_MISC
        conv_ffn_weights(lds, p, l);
        ln_job((const bf16_t*)(ws + OFF_QA), p.ln1_g + l * DM_, p.ln1_b + l * DM_, xb, nullptr);
#endif
        grid_bar(barw, xcc, nloc, nxcd, ++nbar);
        {
            pg8::EpiGU e; e.O = (bf16_t*)(ws + OFF_QA);
            run_gemm(xb, (const bf16_t*)(ws + OFF_WGU), T_, 2 * FF_, DM_, e);
        }
        grid_bar(barw, xcc, nloc, nxcd, ++nbar);
        {
            pg8::EpiResB e; e.Y = (bf16_t*)(ws + OFF_AO); e.X = xb;
            run_gemm((const bf16_t*)(ws + OFF_QA), (const bf16_t*)(ws + OFF_WDN), T_, DM_, FF_, e);
        }
        grid_bar(barw, xcc, nloc, nxcd, ++nbar);
#ifndef NO_MISC
        if (l + 1 < 2) conv_attn_weights(lds, p, l + 1);
        ln_job((const bf16_t*)(ws + OFF_AO), p.ln2_g + l * DM_, p.ln2_b + l * DM_, l + 1 < 2 ? xb : nullptr, l + 1 < 2 ? nullptr : p.out);
#endif
        grid_bar(barw, xcc, nloc, nxcd, ++nbar);
    }
}

extern "C" void kernel_launch(void* const* d_in, const int* in_sizes, int n_in, void* d_out, int out_size, void* d_ws, size_t ws_size, hipStream_t stream) {
    constexpr size_t kDynLds = 131072;
    static int grid_blocks = 0;
    if (!grid_blocks) {
        int dev = 0, cus = 0, per_cu = 0;
        (void)hipGetDevice(&dev);
        (void)hipDeviceGetAttribute(&cus, hipDeviceAttributeMultiprocessorCount, dev);
        (void)hipFuncSetAttribute((const void*)mega, hipFuncAttributeMaxDynamicSharedMemorySize, (int)kDynLds);
        (void)hipOccupancyMaxActiveBlocksPerMultiprocessor(&per_cu, mega, 512, kDynLds);
        if (per_cu < 1) per_cu = 1;
        grid_blocks = cus;
    }
    (void)hipMemsetAsync((unsigned char*)d_ws + OFF_BAR, 0, 16384, stream);
    Params p{};
    p.x = (const float*)d_in[0]; p.pos = (const int*)d_in[1]; p.w_in = (const float*)d_in[2]; p.g_cq = (const float*)d_in[3]; p.g_ckv = (const float*)d_in[4];
    p.w_uq = (const float*)d_in[5]; p.w_ukv = (const float*)d_in[6]; p.w_o = (const float*)d_in[7]; p.ln1_g = (const float*)d_in[8]; p.ln1_b = (const float*)d_in[9];
    p.w_gate = (const float*)d_in[10]; p.w_up = (const float*)d_in[11]; p.w_down = (const float*)d_in[12]; p.ln2_g = (const float*)d_in[13]; p.ln2_b = (const float*)d_in[14];
    p.out = (float*)d_out; p.ws = (unsigned char*)d_ws;
    void* args[] = {&p};
    hipError_t e = hipLaunchCooperativeKernel((void*)mega, dim3(grid_blocks), dim3(512), args, kDynLds, stream);
    if (e != hipSuccess) fprintf(stderr, "cooperative launch failed: %s (grid %d)\n", hipGetErrorString(e), grid_blocks);
}
```

```cpp
#include <hip/hip_runtime.h>
#include <hip/hip_cooperative_groups.h>
#include <cstdio>
namespace cg = cooperative_groups;

constexpr int T_ = 16384, S_ = 4096, NB_ = 4, DM_ = 2048, FF_ = 5632, INC_ = 5008;
constexpr float LOG2E_ = 1.4426950408889634f;
constexpr float QA_SCALE_ = 0.08838834764831845f * LOG2E_;
constexpr float QM_SCALE_ = 0.07216878364870323f * LOG2E_;
constexpr float ALPHA_ = 1.4142135623730951f;
constexpr int RTW_ = 112;

typedef __bf16 bf16x2_t __attribute__((ext_vector_type(2)));
typedef float f32x2_t __attribute__((ext_vector_type(2)));
__device__ __forceinline__ unsigned pk2(float a, float b) { f32x2_t v = {a, b}; bf16x2_t r = __builtin_convertvector(v, bf16x2_t); return __builtin_bit_cast(unsigned, r); }
__device__ __forceinline__ void rot2(float& a, float& b, float c, float s) { const float na = a * c - b * s, nb = b * c + a * s; a = na; b = nb; }

__device__ __forceinline__ int fresh_tid() { int t = (int)threadIdx.x; asm volatile("" : "+v"(t)); return t; }

namespace pg8 {
#define PG8_LAS __attribute__((address_space(3)))
typedef unsigned short bf16_t;
typedef short bf16x8 __attribute__((ext_vector_type(8)));
typedef float f32x4 __attribute__((ext_vector_type(4)));
typedef unsigned u32x4 __attribute__((ext_vector_type(4)));
constexpr int BM = 256, BK = 64, HALF = 128, HTB = HALF * BK * 2  , STAGE_BYTES = 8 * HTB, NXCD = 8, WGM = 8;

__host__ __device__ __forceinline__ int lds_byte(int r, int c) { const int st = (r >> 4) * 2 + (c >> 5), rr = r & 15, cc = c & 31, ob = rr * 64 + cc * 2; return st * 1024 + (ob ^ (((ob >> 9) & 1) << 5)); }
__host__ __device__ __forceinline__ void stage_rc(int b, int& R, int& C) { const int st = b / 1024, sb = b % 1024, swz = sb ^ (((sb >> 9) & 1) << 5); R = (st >> 1) * 16 + swz / 64; C = (st & 1) * 32 + (swz % 64) / 2; }
__host__ __device__ __forceinline__ int perm32(int rho) { const int n = rho >> 4, i = rho & 15; return 8 * (i >> 2) + 4 * n + (i & 3); }

struct Unit { int pm, pn; };
struct Gemm { const bf16_t* A; const bf16_t* Bt; int M, N, K; };

struct StaticOrder {
    int nM, nN, nwg, G, c;
    __host__ __device__ void init(int M, int N, int G_, int c_) { nM = M / BM; nN = N / BM; nwg = nM * nN; G = G_; c = c_; }
    __host__ __device__ bool next(int i, Unit& u) const {
        const long L = (long)i * G + c; if (L >= nwg) return false;
        int wgid = (int)L; { const int q = nwg / NXCD, r = nwg % NXCD, xcd = wgid % NXCD, off = wgid / NXCD; wgid = (xcd < r ? xcd * (q + 1) : r * (q + 1) + (xcd - r) * q) + off; }
        const int nig = WGM * nN, gid = wgid / nig, fm = gid * WGM, gsz = (nM - fm) < WGM ? (nM - fm) : WGM;
        u.pm = fm + ((wgid % nig) % gsz); u.pn = (wgid % nig) / gsz; return true;
    }
    __device__ __forceinline__ void a_ready(const Unit&) const {}
    __device__ __forceinline__ void done(const Unit&) const {}
};
typedef unsigned u32x4_t __attribute__((ext_vector_type(4)));
__device__ __forceinline__ u32x4_t pack8(const f32x4& v0, const f32x4& v1) { u32x4_t w; w.x = pk2(v0[0], v0[1]); w.y = pk2(v0[2], v0[3]); w.z = pk2(v1[0], v1[1]); w.w = pk2(v1[2], v1[3]); return w; }
__device__ __forceinline__ void rope4(f32x4& v0, f32x4& v1, const float* tab) {
    const f32x4 c0 = *(const f32x4*)tab, c1 = *(const f32x4*)(tab + 4);
    const float cs[4] = {c0[0], c0[2], c1[0], c1[2]}, sn[4] = {c0[1], c0[3], c1[1], c1[3]};
#pragma unroll
    for (int j = 0; j < 4; ++j) { const float a = v0[j], b = v1[j]; v0[j] = a * cs[j] - b * sn[j]; v1[j] = b * cs[j] + a * sn[j]; }
}
__device__ __forceinline__ void rope4v(f32x4& v0, f32x4& v1, const f32x4& c0, const f32x4& c1) {
    const float cs[4] = {c0[0], c0[2], c1[0], c1[2]}, sn[4] = {c0[1], c0[3], c1[1], c1[3]};
#pragma unroll
    for (int j = 0; j < 4; ++j) { const float a = v0[j], b = v1[j]; v0[j] = a * cs[j] - b * sn[j]; v1[j] = b * cs[j] + a * sn[j]; }
}
__device__ __forceinline__ float sumsq8(const f32x4& a, const f32x4& b) { return a[0]*a[0] + a[1]*a[1] + a[2]*a[2] + a[3]*a[3] + b[0]*b[0] + b[1]*b[1] + b[2]*b[2] + b[3]*b[3]; }

struct EpiInMain {
    static constexpr int ID = 1; static constexpr bool PERM = true, AFTER_DRAIN = false;
    bf16_t *qa, *ka, *qi, *cq, *ckv, *ki, *kr; float *wi, *rsq, *rskv; const float* rt;
    __device__ __forceinline__ void operator()(const f32x4 (&acc)[2][2][4][2], const Unit& u, int wr, int wc, int fr, int fq) const {
        const int row0 = u.pm * BM + wr * 64 + fr, pn = u.pn, cw = wc * 32 + 8 * fq;
        if (pn < 8) {
            bf16_t* O = pn < 4 ? qa : ka; const int colt = (pn & 3) * 256; const float sc = pn < 4 ? QA_SCALE_ : 1.0f;
#pragma unroll
            for (int ai = 0; ai < 2; ++ai) {
                f32x4 tb[4][2];
                if (wc == 0) {
#pragma unroll
                    for (int m = 0; m < 4; ++m) { const float* tp_ = rt + (size_t)(row0 + ai * HALF + m * 16) * RTW_ + 8 * fq; tb[m][0] = *(const f32x4*)tp_; tb[m][1] = *(const f32x4*)(tp_ + 4); } }
#pragma unroll
                for (int m = 0; m < 4; ++m) { const int row = row0 + ai * HALF + m * 16;
#pragma unroll
                    for (int bj = 0; bj < 2; ++bj) { f32x4 v0 = acc[ai][bj][m][0], v1 = acc[ai][bj][m][1];
                        if (wc == 0) rope4v(v0, v1, tb[m][0], tb[m][1]);
                        v0 *= sc; v1 *= sc;
                        *(u32x4_t*)(O + (size_t)row * 1024 + colt + bj * HALF + cw) = pack8(v0, v1); } } }
        } else if (pn < 12) {
            const int colt = (pn - 8) * 256; const bool rp = ((wc & 1) == 0) && (fq < 2);
#pragma unroll
            for (int ai = 0; ai < 2; ++ai) {
                f32x4 tb[4][2];
                if ((wc & 1) == 0) {
#pragma unroll
                    for (int m = 0; m < 4; ++m) { const float* tp_ = rt + (size_t)(row0 + ai * HALF + m * 16) * RTW_ + 96 + 8 * (fq & 1); tb[m][0] = *(const f32x4*)tp_; tb[m][1] = *(const f32x4*)(tp_ + 4); } }
#pragma unroll
                for (int m = 0; m < 4; ++m) { const int row = row0 + ai * HALF + m * 16;
#pragma unroll
                    for (int bj = 0; bj < 2; ++bj) { f32x4 v0 = acc[ai][bj][m][0], v1 = acc[ai][bj][m][1];
                        if (rp) rope4v(v0, v1, tb[m][0], tb[m][1]);
                        *(u32x4_t*)(qi + (size_t)row * 1024 + colt + bj * HALF + cw) = pack8(v0, v1); } } }
        } else if (pn < 15) {
            const bool isq = pn < 14; bf16_t* O = isq ? cq : ckv; const int ldo = isq ? 512 : 256, colt = isq ? (pn - 12) * 256 : 0;
#pragma unroll
            for (int ai = 0; ai < 2; ++ai)
#pragma unroll
                for (int m = 0; m < 4; ++m) { const int row = row0 + ai * HALF + m * 16; float ss = 0.f;
#pragma unroll
                    for (int bj = 0; bj < 2; ++bj) { const f32x4 v0 = acc[ai][bj][m][0], v1 = acc[ai][bj][m][1]; ss += sumsq8(v0, v1);
                        *(u32x4_t*)(O + (size_t)row * ldo + colt + bj * HALF + cw) = pack8(v0, v1); }
                    ss += __shfl_xor(ss, 16); ss += __shfl_xor(ss, 32);
                    if (fq == 0) { if (isq) rsq[(size_t)row * 8 + (pn - 12) * 4 + wc] = ss; else rskv[(size_t)row * 4 + wc] = ss; } }
        } else {
#pragma unroll
            for (int ai = 0; ai < 2; ++ai)
#pragma unroll
                for (int m = 0; m < 4; ++m) { const int row = row0 + ai * HALF + m * 16;
                    f32x4 v0 = acc[ai][0][m][0], v1 = acc[ai][0][m][1];
                    if (wc < 2) { if (wc == 0 && fq < 2) rope4(v0, v1, rt + (size_t)row * RTW_ + 96 + 8 * fq);
                        *(u32x4_t*)(ki + (size_t)row * 64 + cw) = pack8(v0, v1);
                    } else { const int p0 = cw - 64;
                        rope4(v0, v1, rt + (size_t)row * RTW_ + 32 + p0);
                        *(u32x4_t*)(kr + (size_t)row * 64 + p0) = pack8(v0, v1); }
                    if (wc == 0 && fq < 2) { const f32x4 w0 = acc[ai][1][m][0] * 0.03125f, w1 = acc[ai][1][m][1] * 0.03125f;
                        *(f32x4*)(wi + (size_t)row * 16 + 8 * fq) = w0; *(f32x4*)(wi + (size_t)row * 16 + 8 * fq + 4) = w1; } }
        }
    }
};
struct EpiPlainBf16 {
    static constexpr int ID = 2; static constexpr bool PERM = true, AFTER_DRAIN = false;
    bf16_t* O; int ldc;
    __device__ __forceinline__ void operator()(const f32x4 (&acc)[2][2][4][2], const Unit& u, int wr, int wc, int fr, int fq) const {
        const int row0 = u.pm * BM + wr * 64 + fr, col0 = u.pn * BM + wc * 32 + 8 * fq;
#pragma unroll
        for (int ai = 0; ai < 2; ++ai)
#pragma unroll
            for (int m = 0; m < 4; ++m) { bf16_t* rowp = O + (size_t)(row0 + ai * HALF + m * 16) * ldc + col0;
#pragma unroll
                for (int bj = 0; bj < 2; ++bj) *(u32x4_t*)(rowp + bj * HALF) = pack8(acc[ai][bj][m][0], acc[ai][bj][m][1]); }
    }
};
struct EpiUq {
    static constexpr int ID = 4; static constexpr bool PERM = true, AFTER_DRAIN = false;
    bf16_t* O; const float* rsq; const float* rt;
    __device__ __forceinline__ void operator()(const f32x4 (&acc)[2][2][4][2], const Unit& u, int wr, int wc, int fr, int fq) const {
        const int row0 = u.pm * BM + wr * 64 + fr;
#pragma unroll
        for (int ai = 0; ai < 2; ++ai) {
            f32x4 pq[4][2];
#pragma unroll
            for (int m = 0; m < 4; ++m) { const float* rp_ = rsq + (size_t)(row0 + ai * HALF + m * 16) * 8; pq[m][0] = *(const f32x4*)rp_; pq[m][1] = *(const f32x4*)(rp_ + 4); }
#pragma unroll
            for (int m = 0; m < 4; ++m) { const int row = row0 + ai * HALF + m * 16;
                const f32x4 p0 = pq[m][0], p1 = pq[m][1];
                const float ssum = ((p0[0] + p0[1]) + (p0[2] + p0[3])) + ((p1[0] + p1[1]) + (p1[2] + p1[3]));
                const float sc = __builtin_amdgcn_rsqf(ssum * (1.0f / 512.0f) + 1e-6f) * QM_SCALE_;
#pragma unroll
                for (int bj = 0; bj < 2; ++bj) { const int c = u.pn * BM + bj * HALF + wc * 32 + 8 * fq; const int within = c % 192;
                    f32x4 v0 = acc[ai][bj][m][0], v1 = acc[ai][bj][m][1];
                    if (within >= 128) rope4(v0, v1, rt + (size_t)row * RTW_ + 32 + (within - 128));
                    v0 *= sc; v1 *= sc;
                    *(u32x4_t*)(O + (size_t)row * 1536 + c) = pack8(v0, v1); } } }
    }
};
struct EpiUkvK {
    static constexpr int ID = 8; static constexpr bool PERM = true, AFTER_DRAIN = false;
    bf16_t* O; const float* rskv;
    __device__ __forceinline__ void operator()(const f32x4 (&acc)[2][2][4][2], const Unit& u, int wr, int wc, int fr, int fq) const {
        const int row0 = u.pm * BM + wr * 64 + fr, col0 = u.pn * BM + wc * 32 + 8 * fq;
#pragma unroll
        for (int ai = 0; ai < 2; ++ai) {
            f32x4 pk[4];
#pragma unroll
            for (int m = 0; m < 4; ++m) pk[m] = *(const f32x4*)(rskv + (size_t)(row0 + ai * HALF + m * 16) * 4);
#pragma unroll
            for (int m = 0; m < 4; ++m) { const int row = row0 + ai * HALF + m * 16;
                const f32x4 p0 = pk[m];
                const float sc = __builtin_amdgcn_rsqf(((p0[0] + p0[1]) + (p0[2] + p0[3])) * (1.0f / 256.0f) + 1e-6f);
#pragma unroll
                for (int bj = 0; bj < 2; ++bj) { f32x4 v0 = acc[ai][bj][m][0] * sc, v1 = acc[ai][bj][m][1] * sc;
                    *(u32x4_t*)(O + (size_t)row * 1024 + col0 + bj * HALF) = pack8(v0, v1); } } }
    }
};
struct EpiUkvV {
    static constexpr int ID = 16; static constexpr bool PERM = true, AFTER_DRAIN = false;
    bf16_t* O; const float* rskv;
    __device__ __forceinline__ void operator()(const f32x4 (&acc)[2][2][4][2], const Unit& u, int wr, int wc, int fr, int fq) const {
        const int row0 = u.pm * BM + wr * 64 + fr, col0 = u.pn * BM + wc * 32 + 8 * fq;
#pragma unroll
        for (int bj = 0; bj < 2; ++bj) { const int c = col0 + bj * HALF; f32x4 s0, s1;
#pragma unroll
            for (int j = 0; j < 4; ++j) { const f32x4 a = *(const f32x4*)(rskv + (size_t)(c + j) * 4), b = *(const f32x4*)(rskv + (size_t)(c + 4 + j) * 4);
                s0[j] = __builtin_amdgcn_rsqf(((a[0] + a[1]) + (a[2] + a[3])) * (1.0f / 256.0f) + 1e-6f);
                s1[j] = __builtin_amdgcn_rsqf(((b[0] + b[1]) + (b[2] + b[3])) * (1.0f / 256.0f) + 1e-6f); }
#pragma unroll
            for (int ai = 0; ai < 2; ++ai)
#pragma unroll
                for (int m = 0; m < 4; ++m) { const f32x4 v0 = acc[ai][bj][m][0] * s0, v1 = acc[ai][bj][m][1] * s1;
                    *(u32x4_t*)(O + (size_t)(row0 + ai * HALF + m * 16) * T_ + c) = pack8(v0, v1); } }
    }
};
__device__ __forceinline__ f32x4 bf16lo4(unsigned a, unsigned b) { f32x4 r; r[0] = __uint_as_float(a << 16); r[1] = __uint_as_float(a & 0xffff0000u); r[2] = __uint_as_float(b << 16); r[3] = __uint_as_float(b & 0xffff0000u); return r; }
struct EpiResB {
    static constexpr int ID = 32; static constexpr bool PERM = true, AFTER_DRAIN = false;
    bf16_t* Y; const bf16_t* X;
    __device__ __forceinline__ void operator()(const f32x4 (&acc)[2][2][4][2], const Unit& u, int wr, int wc, int fr, int fq) const {
        const int row0 = u.pm * BM + wr * 64 + fr, col0 = u.pn * BM + wc * 32 + 8 * fq;
        u32x4_t xw[2][4][2];
#pragma unroll
        for (int ai = 0; ai < 2; ++ai)
#pragma unroll
            for (int m = 0; m < 4; ++m)
#pragma unroll
                for (int bj = 0; bj < 2; ++bj) xw[ai][m][bj] = *(const u32x4_t*)(X + (size_t)(row0 + ai * HALF + m * 16) * DM_ + col0 + bj * HALF);
#pragma unroll
        for (int ai = 0; ai < 2; ++ai)
#pragma unroll
            for (int m = 0; m < 4; ++m) { const size_t ro = (size_t)(row0 + ai * HALF + m * 16) * DM_ + col0;
#pragma unroll
                for (int bj = 0; bj < 2; ++bj) { const u32x4_t x4 = xw[ai][m][bj];
                    const f32x4 v0 = bf16lo4(x4.x, x4.y) * ALPHA_ + acc[ai][bj][m][0], v1 = bf16lo4(x4.z, x4.w) * ALPHA_ + acc[ai][bj][m][1];
                    *(u32x4_t*)(Y + ro + bj * HALF) = pack8(v0, v1); } }
    }
};
struct EpiGU {
    static constexpr int ID = 64; static constexpr bool PERM = true, AFTER_DRAIN = false;
    bf16_t* O;
    __device__ __forceinline__ void operator()(const f32x4 (&acc)[2][2][4][2], const Unit& u, int wr, int wc, int fr, int fq) const {
        const int row0 = u.pm * BM + wr * 64 + fr, col0 = u.pn * HALF + wc * 32 + 8 * fq;
#pragma unroll
        for (int ai = 0; ai < 2; ++ai)
#pragma unroll
            for (int m = 0; m < 4; ++m) { f32x4 h0, h1;
#pragma unroll
                for (int j = 0; j < 4; ++j) { const float g0 = acc[ai][0][m][0][j], g1 = acc[ai][0][m][1][j];
                    h0[j] = g0 * __builtin_amdgcn_rcpf(1.0f + __builtin_amdgcn_exp2f(-g0 * LOG2E_)) * acc[ai][1][m][0][j];
                    h1[j] = g1 * __builtin_amdgcn_rcpf(1.0f + __builtin_amdgcn_exp2f(-g1 * LOG2E_)) * acc[ai][1][m][1][j]; }
                *(u32x4_t*)(O + (size_t)(row0 + ai * HALF + m * 16) * FF_ + col0) = pack8(h0, h1); }
    }
};


template <class Epi, class Sched, bool ALIGN_EPI = false, bool SP2 = false>
__device__ __forceinline__ void gemm_phase(PG8_LAS unsigned char* lds, const Gemm g, const Sched& S, const Epi& E) {
    const int tid = fresh_tid(), wid = __builtin_amdgcn_readfirstlane(tid >> 6), lane = tid & 63, wr = wid >> 2, wc = wid & 3, fr = lane & 15, fq = lane >> 4;
    const int K = g.K, nt = K / BK;
    unsigned voffA[2], voffB[2];
#pragma unroll
    for (int i = 0; i < 2; ++i) { int R, C; stage_rc(tid * 16 + i * 8192, R, C); const int Rb = Epi::PERM ? ((R & ~31) + perm32(R & 31)) : R;
        voffA[i] = (unsigned)(R * K + C) * 2u; voffB[i] = (unsigned)(Rb * K + C) * 2u; }
    const size_t kstep = (size_t)(BK * 2);
    const size_t hstep = (size_t)HALF * K * 2;
    const size_t tstep = 2 * hstep;
    const unsigned ldsw = (unsigned)wid * 1024u;
    const int aoff = lds_byte(wr * 64 + fr, fq * 8), boff = lds_byte(wc * 32 + fr, fq * 8);
#define PG8_SA(b, h) (((b) * 2 + (h)) * HTB)
#define PG8_SB(b, h) ((4 + (b) * 2 + (h)) * HTB)
#define PG8_STAGE(bufoff, gbase, voff) do { _Pragma("unroll") for (int _i = 0; _i < 2; ++_i) \
        __builtin_amdgcn_global_load_lds((const unsigned*)((const char*)(gbase) + (voff)[_i]), (PG8_LAS unsigned*)(lds + (bufoff) + ldsw + _i * 8192), 16, 0, 0); } while (0)
#define PG8_LDA(dst, b, h) do { _Pragma("unroll") for (int m = 0; m < 4; ++m) _Pragma("unroll") for (int k = 0; k < 2; ++k) dst[m][k] = *(const PG8_LAS bf16x8*)(lds + PG8_SA(b, h) + aoff + m * 2048 + k * 1024); } while (0)
#define PG8_LDB(dst, b, h) do { _Pragma("unroll") for (int n = 0; n < 2; ++n) _Pragma("unroll") for (int k = 0; k < 2; ++k) dst[n][k] = *(const PG8_LAS bf16x8*)(lds + PG8_SB(b, h) + boff + n * 2048 + k * 1024); } while (0)
#define PG8_MMA(ai, bj, At, Bt) do { __builtin_amdgcn_s_setprio(1); _Pragma("unroll") for (int m = 0; m < 4; ++m) _Pragma("unroll") for (int n = 0; n < 2; ++n) _Pragma("unroll") for (int k = 0; k < 2; ++k) \
        acc[ai][bj][m][n] = __builtin_amdgcn_mfma_f32_16x16x32_bf16(Bt[n][k], At[m][k], acc[ai][bj][m][n], 0, 0, 0); __builtin_amdgcn_s_setprio(0); } while (0)
#define PG8_WAIT_V(n) asm volatile("s_waitcnt vmcnt(" #n ")" ::: "memory")
#define PG8_WAIT_L(n) asm volatile("s_waitcnt lgkmcnt(" #n ")" ::: "memory")
#define PG8_BAR __builtin_amdgcn_s_barrier()
#define PG8_SCHED __builtin_amdgcn_sched_barrier(0)
    Unit cur, nxt; int ui = 0;
    if (!S.next(0, cur)) return;
    f32x4 acc[2][2][4][2];
#pragma unroll
    for (int a = 0; a < 2; ++a)
#pragma unroll
        for (int b = 0; b < 2; ++b)
#pragma unroll
            for (int m = 0; m < 4; ++m)
#pragma unroll
                for (int n = 0; n < 2; ++n) acc[a][b][m][n] = (f32x4){0.f, 0.f, 0.f, 0.f};
    bf16x8 At[4][2], B0[2][2], B1[2][2];
    const char* cA = (const char*)g.A + (size_t)cur.pm * tstep; const char* cB = (const char*)g.Bt + (size_t)cur.pn * tstep;
    S.a_ready(cur);
    if constexpr (SP2) {
        PG8_STAGE(PG8_SB(0, 0), cB, voffB); PG8_STAGE(PG8_SB(0, 1), cB + hstep, voffB); PG8_STAGE(PG8_SA(0, 0), cA, voffA); PG8_STAGE(PG8_SA(0, 1), cA + hstep, voffA);
        if (wr == 1) PG8_BAR;
        PG8_WAIT_V(2); PG8_BAR;
        PG8_STAGE(PG8_SB(1, 0), cB + kstep, voffB); PG8_STAGE(PG8_SA(1, 0), cA + kstep, voffA); PG8_STAGE(PG8_SB(1, 1), cB + hstep + kstep, voffB);
        PG8_WAIT_V(6); PG8_BAR;
    } else {
        PG8_STAGE(PG8_SB(0, 0), cB, voffB); PG8_STAGE(PG8_SA(0, 0), cA, voffA); PG8_STAGE(PG8_SB(0, 1), cB + hstep, voffB); PG8_STAGE(PG8_SA(0, 1), cA + hstep, voffA);
        if (wr == 1) PG8_BAR;
        PG8_WAIT_V(4); PG8_BAR;
        PG8_STAGE(PG8_SB(1, 0), cB + kstep, voffB); PG8_STAGE(PG8_SA(1, 0), cA + kstep, voffA); PG8_STAGE(PG8_SB(1, 1), cB + hstep + kstep, voffB);
        PG8_WAIT_V(6); PG8_BAR;
    }
    for (;;) {
        const bool has_next = S.next(ui + 1, nxt);
        const char* nA = has_next ? (const char*)g.A + (size_t)nxt.pm * tstep : cA; const char* nB = has_next ? (const char*)g.Bt + (size_t)nxt.pn * tstep : cB;
        for (int t = 0; t < nt; t += 2) {
            const bool last = (t == nt - 2);
            const char* a1 = cA + (size_t)(t + 1) * kstep;
            const char* a2 = last ? nA : cA + (size_t)(t + 2) * kstep; const char* b2 = last ? nB : cB + (size_t)(t + 2) * kstep;
            const char* a3 = a2 + kstep; const char* b3 = b2 + kstep;
            if (last && has_next) S.a_ready(nxt);
            if constexpr (SP2) {
            PG8_LDB(B0, 0, 0); PG8_LDB(B1, 0, 1); PG8_SCHED; PG8_LDA(At, 0, 0); PG8_STAGE(PG8_SA(1, 1), a1 + hstep, voffA);
            PG8_WAIT_V(8); PG8_WAIT_L(0); PG8_BAR; PG8_MMA(0, 0, At, B0); PG8_MMA(0, 1, At, B1); PG8_BAR; PG8_SCHED;
            PG8_LDA(At, 0, 1); PG8_STAGE(PG8_SB(0, 0), b2, voffB); PG8_STAGE(PG8_SB(0, 1), b2 + hstep, voffB); PG8_STAGE(PG8_SA(0, 0), a2, voffA);
            PG8_WAIT_V(8); PG8_WAIT_L(0); PG8_BAR; PG8_MMA(1, 0, At, B0); PG8_MMA(1, 1, At, B1); PG8_BAR; PG8_SCHED;
            PG8_LDB(B0, 1, 0); PG8_LDB(B1, 1, 1); PG8_SCHED; PG8_LDA(At, 1, 0); PG8_STAGE(PG8_SA(0, 1), a2 + hstep, voffA);
            PG8_WAIT_V(8); PG8_WAIT_L(0); PG8_BAR; PG8_MMA(0, 0, At, B0); PG8_MMA(0, 1, At, B1); PG8_BAR; PG8_SCHED;
            PG8_LDA(At, 1, 1); PG8_STAGE(PG8_SB(1, 0), b3, voffB); PG8_STAGE(PG8_SB(1, 1), b3 + hstep, voffB); PG8_STAGE(PG8_SA(1, 0), a3, voffA);
            PG8_WAIT_V(8); PG8_WAIT_L(0); PG8_BAR; PG8_MMA(1, 0, At, B0); PG8_MMA(1, 1, At, B1); PG8_BAR; PG8_SCHED;
            } else {
            PG8_LDB(B0, 0, 0); PG8_SCHED; PG8_LDA(At, 0, 0); PG8_STAGE(PG8_SA(1, 1), a1 + hstep, voffA);
            PG8_WAIT_L(8); PG8_BAR; PG8_WAIT_L(0); PG8_MMA(0, 0, At, B0); PG8_BAR; PG8_SCHED;
            PG8_LDB(B1, 0, 1); PG8_STAGE(PG8_SB(0, 0), b2, voffB);
            PG8_BAR; PG8_WAIT_L(0); PG8_MMA(0, 1, At, B1); PG8_BAR;
            PG8_LDA(At, 0, 1); PG8_STAGE(PG8_SA(0, 0), a2, voffA);
            PG8_BAR; PG8_WAIT_L(0); PG8_MMA(1, 0, At, B0); PG8_BAR; PG8_SCHED;
            PG8_STAGE(PG8_SB(0, 1), b2 + hstep, voffB);
            PG8_WAIT_V(6); PG8_BAR; PG8_MMA(1, 1, At, B1); PG8_BAR;
            PG8_LDB(B0, 1, 0); PG8_SCHED; PG8_LDA(At, 1, 0); PG8_STAGE(PG8_SA(0, 1), a2 + hstep, voffA);
            PG8_WAIT_L(8); PG8_BAR; PG8_WAIT_L(0); PG8_MMA(0, 0, At, B0); PG8_BAR; PG8_SCHED;
            PG8_LDB(B1, 1, 1); PG8_STAGE(PG8_SB(1, 0), b3, voffB);
            PG8_BAR; PG8_WAIT_L(0); PG8_MMA(0, 1, At, B1); PG8_BAR;
            PG8_LDA(At, 1, 1); PG8_STAGE(PG8_SA(1, 0), a3, voffA);
            PG8_BAR; PG8_WAIT_L(0); PG8_MMA(1, 0, At, B0); PG8_BAR; PG8_SCHED;
            PG8_STAGE(PG8_SB(1, 1), b3 + hstep, voffB);
            PG8_WAIT_V(6); PG8_BAR; PG8_MMA(1, 1, At, B1); PG8_BAR;
            }
        }
        if constexpr (ALIGN_EPI) { if (wr == 0) PG8_BAR; }
        if constexpr (!Epi::AFTER_DRAIN) { E(acc, cur, wr, wc, fr, fq); S.done(cur); }
        if (!has_next) break;
#pragma unroll
        for (int a = 0; a < 2; ++a)
#pragma unroll
            for (int b = 0; b < 2; ++b)
#pragma unroll
                for (int m = 0; m < 4; ++m)
#pragma unroll
                    for (int n = 0; n < 2; ++n) acc[a][b][m][n] = (f32x4){0.f, 0.f, 0.f, 0.f};
        cur = nxt; cA = nA; cB = nB; ++ui;
        if constexpr (ALIGN_EPI) { if (wr == 1) PG8_BAR; }
    }
    PG8_WAIT_V(0);
    if constexpr (!ALIGN_EPI) { if (wr == 0) PG8_BAR; }
    PG8_BAR;
    if constexpr (Epi::AFTER_DRAIN) { E.fused(acc, cur, wr, wc, fr, fq, lds, wid, lane); S.done(cur); }
#undef PG8_SA
#undef PG8_SB
#undef PG8_STAGE
#undef PG8_LDA
#undef PG8_LDB
#undef PG8_MMA
#undef PG8_WAIT_V
#undef PG8_WAIT_L
#undef PG8_BAR
#undef PG8_SCHED
}
}


using pg8::bf16_t; using pg8::bf16x8; using pg8::f32x4; using pg8::u32x4_t;
typedef float f32x16 __attribute__((ext_vector_type(16)));
typedef short s16x4 __attribute__((ext_vector_type(4)));
#define MFMA32(a, b, c) __builtin_amdgcn_mfma_f32_32x32x16_bf16((a), (b), (c), 0, 0, 0)

constexpr size_t OFF_WIN = 0;
constexpr size_t OFF_WVA = OFF_WIN + 4096ull * 2048 * 2;
constexpr size_t OFF_WUQ = OFF_WVA + 1024ull * 2048 * 2;
constexpr size_t OFF_WUKK = OFF_WUQ + 1536ull * 512 * 2;
constexpr size_t OFF_WUKV = OFF_WUKK + 1024ull * 256 * 2;
constexpr size_t OFF_WO = OFF_WUKV + 1024ull * 256 * 2;
constexpr size_t OFF_RT = OFF_WO + 2048ull * 2048 * 2;
constexpr size_t OFF_MASK = OFF_RT + (size_t)T_ * RTW_ * 4;
constexpr size_t OFF_KNOPE = OFF_MASK + (size_t)T_ * 128 * 4;
constexpr size_t OFF_VTB = OFF_KNOPE + (size_t)T_ * 1024 * 2;
constexpr size_t OFF_WGU = OFF_VTB + (size_t)T_ * 1024 * 2;
constexpr size_t OFF_WDN = OFF_WGU + 11264ull * 2048 * 2;
constexpr size_t OFF_XB = OFF_WDN + 2048ull * 5632 * 2;
constexpr size_t OFF_QA = OFF_XB + (size_t)T_ * 2048 * 2;
constexpr size_t OFF_KA = OFF_QA + (size_t)T_ * 1024 * 2;
constexpr size_t OFF_QI = OFF_KA + (size_t)T_ * 1024 * 2;
constexpr size_t OFF_VTA = OFF_QI + (size_t)T_ * 1024 * 2;
constexpr size_t OFF_CQ = OFF_VTA + (size_t)T_ * 1024 * 2;
constexpr size_t OFF_CKV = OFF_CQ + (size_t)T_ * 512 * 2;
constexpr size_t OFF_KI = OFF_CKV + (size_t)T_ * 256 * 2;
constexpr size_t OFF_KR = OFF_KI + (size_t)T_ * 64 * 2;
constexpr size_t OFF_WI = OFF_KR + (size_t)T_ * 64 * 2;
constexpr size_t OFF_RSQ = OFF_WI + (size_t)T_ * 16 * 4;
constexpr size_t OFF_RSKV = OFF_RSQ + (size_t)T_ * 8 * 4;
constexpr size_t OFF_QM = OFF_RSKV + (size_t)T_ * 4 * 4;
constexpr size_t WS_END = OFF_QM + (size_t)T_ * 1536 * 2;
constexpr size_t OFF_AO = WS_END;
constexpr size_t OFF_BAR = OFF_AO + (size_t)T_ * 2048 * 2;
static_assert(OFF_BAR + 16384 <= 536870912ull, "workspace");
static_assert(WS_END - OFF_QA >= (size_t)T_ * 5632 * 2, "h");

struct Params {
    const float* x; const int* pos; const float *w_in, *g_cq, *g_ckv, *w_uq, *w_ukv, *w_o, *ln1_g, *ln1_b, *w_gate, *w_up, *w_down, *ln2_g, *ln2_b;
    float* out; unsigned char* ws;
};

__device__ __forceinline__ int ropeA(int w) { if (w >= 32) return w; const int g = w >> 3, e = w & 7; return e < 4 ? 4 * g + e : 16 + 4 * g + (e - 4); }
__device__ __forceinline__ int ropeI(int w) { if (w >= 16) return w; const int g = w >> 3, e = w & 7; return e < 4 ? 4 * g + e : 8 + 4 * g + (e - 4); }
__device__ __forceinline__ int ropeM(int p) { const int g = p >> 3, e = p & 7; return e < 4 ? 4 * g + e : 32 + 4 * g + (e - 4); }
struct MapInMain { const float* w; __device__ __forceinline__ const float* operator()(int n) const {
    const int tile = n >> 8, c = n & 255; int src;
    if (tile < 8) { const int col = (tile & 3) * 256 + c, head = col >> 7, wd = col & 127; src = (tile < 4 ? 0 : 1024) + head * 128 + ropeA(wd); }
    else if (tile < 12) { const int col = (tile - 8) * 256 + c, head = col >> 6, wd = col & 63; src = 3072 + head * 64 + ropeI(wd); }
    else if (tile < 14) src = 4176 + (tile - 12) * 256 + c;
    else if (tile == 14) src = 4688 + c;
    else { if (c < 64) src = 4112 + ropeI(c); else if (c < 128) src = 4944 + ropeM(c - 64); else if (c < 144) src = 4096 + (c - 128); else return nullptr; }
    return w + src; } };
struct MapOff { const float* w; __device__ __forceinline__ const float* operator()(int n) const { return w + n; } };
struct MapUq { const float* w; __device__ __forceinline__ const float* operator()(int n) const { const int head = n / 192, wd = n % 192; return w + head * 192 + (wd < 128 ? wd : 128 + ropeM(wd - 128)); } };
struct MapUkv { const float* w; __device__ __forceinline__ const float* operator()(int n) const { return w + (n >> 7) * 256 + (n & 127); } };
struct MapGU { const float *g, *u; __device__ __forceinline__ const float* operator()(int n) const { const int tile = n >> 8, c = n & 255; return c < 128 ? g + tile * 128 + c : u + tile * 128 + (c - 128); } };

template <class Map>
__device__ __forceinline__ void conv_job(unsigned char* lds, const Map map, int ldsrc, int K, int Nd, bf16_t* dst, const float* gain, int& base) {
    const int tid = fresh_tid(), G = gridDim.x; unsigned short* tile = (unsigned short*)lds;
    const int nkt = K / 64, ntiles = (Nd / 64) * nkt, nn = tid & 63, kq = tid >> 6;
    const int first = ((int)blockIdx.x - base % G + G) % G;
    float v[8], vn[8];
#define CONV_LOAD(dst_, i_) do { const int n0_ = ((i_) / nkt) * 64, k0_ = ((i_) % nkt) * 64; const float* cp_ = map(n0_ + nn); \
        _Pragma("unroll") for (int r = 0; r < 8; ++r) { const int kk_ = r * 8 + kq; float x_ = cp_ ? cp_[(size_t)(k0_ + kk_) * ldsrc] : 0.f; if (gain) x_ *= gain[k0_ + kk_]; (dst_)[r] = x_; } } while (0)
    if (first < ntiles) CONV_LOAD(v, first);
    for (int i = first; i < ntiles; i += G) {
        const int n0 = (i / nkt) * 64, k0 = (i % nkt) * 64;
        if (i + G < ntiles) CONV_LOAD(vn, i + G);
#pragma unroll
        for (int r = 0; r < 8; ++r) tile[nn * 66 + r * 8 + kq] = (unsigned short)(pk2(v[r], 0.f) & 0xffffu);
        __syncthreads();
        { const int rn = tid >> 3, pc = tid & 7; const unsigned* s = (const unsigned*)(tile + rn * 66 + pc * 8); uint4 w; w.x = s[0]; w.y = s[1]; w.z = s[2]; w.w = s[3];
          *(uint4*)(dst + (size_t)(n0 + rn) * K + k0 + pc * 8) = w; }
        __syncthreads();
#pragma unroll
        for (int r = 0; r < 8; ++r) v[r] = vn[r];
    }
#undef CONV_LOAD
    base += ntiles;
}
__device__ __forceinline__ void conv_attn_weights(unsigned char* lds, const Params& p, int l) {
    int base = 0; unsigned char* ws = p.ws;
    const float* w_in = p.w_in + (size_t)l * DM_ * INC_;
    conv_job(lds, MapInMain{w_in}, INC_, DM_, 4096, (bf16_t*)(ws + OFF_WIN), nullptr, base);
    conv_job(lds, MapOff{w_in + 2048}, INC_, DM_, 1024, (bf16_t*)(ws + OFF_WVA), nullptr, base);
    conv_job(lds, MapUq{p.w_uq + (size_t)l * 512 * 1536}, 1536, 512, 1536, (bf16_t*)(ws + OFF_WUQ), p.g_cq + l * 512, base);
    conv_job(lds, MapUkv{p.w_ukv + (size_t)l * 256 * 2048}, 2048, 256, 1024, (bf16_t*)(ws + OFF_WUKK), p.g_ckv + l * 256, base);
    conv_job(lds, MapUkv{p.w_ukv + (size_t)l * 256 * 2048 + 128}, 2048, 256, 1024, (bf16_t*)(ws + OFF_WUKV), p.g_ckv + l * 256, base);
    conv_job(lds, MapOff{p.w_o + (size_t)l * 2048 * 2048}, 2048, 2048, 2048, (bf16_t*)(ws + OFF_WO), nullptr, base);
}
__device__ __forceinline__ void conv_ffn_weights(unsigned char* lds, const Params& p, int l) {
    int base = 0; unsigned char* ws = p.ws;
    conv_job(lds, MapGU{p.w_gate + (size_t)l * DM_ * FF_, p.w_up + (size_t)l * DM_ * FF_}, FF_, DM_, 2 * FF_, (bf16_t*)(ws + OFF_WGU), nullptr, base);
    conv_job(lds, MapOff{p.w_down + (size_t)l * FF_ * DM_}, DM_, FF_, DM_, (bf16_t*)(ws + OFF_WDN), nullptr, base);
}
__device__ __forceinline__ void rope_table_job(const int* pos, float* rt) {
    const int tid = fresh_tid();
    for (int idx = blockIdx.x * 512 + tid; idx < T_ * 56; idx += gridDim.x * 512) {
        const int t = idx / 56, f = idx % 56; float theta, e;
        if (f < 16) { theta = 500000.0f; e = (-2.0f * (float)f) / 32.0f; } else if (f < 48) { theta = 10000.0f; e = (-2.0f * (float)(f - 16)) / 64.0f; } else { theta = 500000.0f; e = (-2.0f * (float)(f - 48)) / 16.0f; }
        const float inv = powf(theta, e), ang = (float)pos[t] * inv; float s, c; sincosf(ang, &s, &c);
        rt[(size_t)t * RTW_ + 2 * f] = c; rt[(size_t)t * RTW_ + 2 * f + 1] = s; }
}
__device__ __forceinline__ void x_to_bf16_job(const float* x, bf16_t* xb) {
    const int tid = fresh_tid();
    const size_t n = (size_t)T_ * DM_ / 8, step = (size_t)gridDim.x * 512;
    size_t i = (size_t)blockIdx.x * 512 + tid;
    for (; i + 3 * step < n; i += 4 * step) {
        f32x4 a[4], b[4];
#pragma unroll
        for (int u = 0; u < 4; ++u) { a[u] = *(const f32x4*)(x + (i + u * step) * 8); b[u] = *(const f32x4*)(x + (i + u * step) * 8 + 4); }
#pragma unroll
        for (int u = 0; u < 4; ++u) *(u32x4_t*)(xb + (i + u * step) * 8) = pg8::pack8(a[u], b[u]);
    }
    for (; i < n; i += step) { const f32x4 a = *(const f32x4*)(x + i * 8), b = *(const f32x4*)(x + i * 8 + 4); *(u32x4_t*)(xb + i * 8) = pg8::pack8(a, b); }
}
__device__ __forceinline__ float wave_sum(float v) {
#pragma unroll
    for (int o = 32; o >= 1; o >>= 1) v += __shfl_xor(v, o);
    return v; }
__device__ __forceinline__ void ln_job(const bf16_t* y, const float* g, const float* bta, bf16_t* xb, float* outf) {
    const int tid = fresh_tid(), wv = tid >> 6, lane = tid & 63, step = gridDim.x * 8;
    int row = blockIdx.x * 8 + wv;
    u32x4_t w[4], wn[4];
#pragma unroll
    for (int i = 0; i < 4; ++i) { w[i] = (u32x4_t){0u, 0u, 0u, 0u}; wn[i] = w[i]; }
    f32x4 gv[8], bv[8];
#pragma unroll
    for (int i = 0; i < 4; ++i) { const int c = 8 * lane + 512 * i; gv[2 * i] = *(const f32x4*)(g + c); gv[2 * i + 1] = *(const f32x4*)(g + c + 4); bv[2 * i] = *(const f32x4*)(bta + c); bv[2 * i + 1] = *(const f32x4*)(bta + c + 4); }
    if (row < T_) {
#pragma unroll
        for (int i = 0; i < 4; ++i) w[i] = *(const u32x4_t*)(y + (size_t)row * DM_ + 8 * lane + 512 * i); }
    for (; row < T_; row += step) {
        if (row + step < T_) {
#pragma unroll
            for (int i = 0; i < 4; ++i) wn[i] = *(const u32x4_t*)(y + (size_t)(row + step) * DM_ + 8 * lane + 512 * i); }
        f32x4 v[8]; float s = 0.f;
#pragma unroll
        for (int i = 0; i < 4; ++i) { v[2 * i] = pg8::bf16lo4(w[i].x, w[i].y); v[2 * i + 1] = pg8::bf16lo4(w[i].z, w[i].w); }
        float q = 0.f;
#pragma unroll
        for (int i = 0; i < 8; ++i) { s += (v[i][0] + v[i][1]) + (v[i][2] + v[i][3]); q += (v[i][0] * v[i][0] + v[i][1] * v[i][1]) + (v[i][2] * v[i][2] + v[i][3] * v[i][3]); }
        const float ssum = wave_sum(s), qsum = wave_sum(q);
        const float mu = ssum * (1.0f / DM_), var = fmaxf(qsum * (1.0f / DM_) - mu * mu, 0.0f);
#pragma unroll
        for (int i = 0; i < 8; ++i) v[i] -= mu;
        const float rstd = 1.0f / sqrtf(var + 1e-5f);
#pragma unroll
        for (int i = 0; i < 4; ++i) { const int c = 8 * lane + 512 * i;
            const f32x4 o0 = v[2 * i] * rstd * gv[2 * i] + bv[2 * i], o1 = v[2 * i + 1] * rstd * gv[2 * i + 1] + bv[2 * i + 1];
            if (xb) *(u32x4_t*)(xb + (size_t)row * DM_ + c) = pg8::pack8(o0, o1);
            if (outf) { *(f32x4*)(outf + (size_t)row * DM_ + c) = o0; *(f32x4*)(outf + (size_t)row * DM_ + c + 4) = o1; } }
#pragma unroll
        for (int i = 0; i < 4; ++i) w[i] = wn[i];
    }
}
__device__ __forceinline__ unsigned f2key(float f) { const unsigned u = __float_as_uint(f); return (u & 0x80000000u) ? ~u : (u | 0x80000000u); }
template <int NR>
__device__ __forceinline__ unsigned long long topk_row(const float* sc, int q, int lane) {
    unsigned key[NR];
#pragma unroll
    for (int r = 0; r < NR; ++r) { const int pp = 64 * r + lane; const float f = __hip_atomic_load(sc + pp, __ATOMIC_RELAXED, __HIP_MEMORY_SCOPE_AGENT); key[r] = (pp <= q) ? f2key(f) : 0u; }
    unsigned lo = 0u, hi = 0xFFFFFFFFu;
    while (hi - lo > 1u) {
        const unsigned mid = lo + ((hi - lo) >> 1); int c = 0;
#pragma unroll
        for (int r = 0; r < NR; ++r) c += __popcll(__ballot(key[r] > mid));
        if (c > 256) lo = mid; else { hi = mid; if (c == 256) break; }
    }
    unsigned long long mine = 0ull;
#pragma unroll
    for (int r = 0; r < NR; ++r) { const unsigned long long bl = __ballot(key[r] > hi); if (lane == r) mine = bl; }
    return mine;
}
typedef float f32x4v __attribute__((ext_vector_type(4)));
#define MFMA16(a, b, c) __builtin_amdgcn_mfma_f32_16x16x32_bf16((a), (b), (c), 0, 0, 0)
__device__ __forceinline__ float relu1(float x) { const int i = __float_as_int(x); return __int_as_float(i > 0 ? i : 0); }
__device__ __forceinline__ float key2f(unsigned k) { return __uint_as_float((k & 0x80000000u) ? (k & 0x7fffffffu) : ~k); }
__device__ __forceinline__ float zscore_of_count(float c, float rn) {
    const float p = c * rn, q = fmaxf(p > 0.5f ? 1.0f - p : p, 1e-7f);
    const float tt = sqrtf(-1.3862943611f * __builtin_amdgcn_logf(q));
    const float zz = tt - (2.30753f + 0.27061f * tt) * __builtin_amdgcn_rcpf(1.0f + tt * (0.99229f + 0.04481f * tt));
    return p > 0.5f ? -zz : zz; }
__device__ __forceinline__ void indexer_job(unsigned char* lds, const bf16_t* qi, const bf16_t* ki, const float* wi, unsigned* mask) {
    for (int pr = blockIdx.x; pr < 256; pr += gridDim.x) {
        const int b = pr >> 6, ip = pr & 63;
        uint4 pfq[4]; float pfw = 0.f;
#pragma unroll
        for (int r = 0; r < 4; ++r) pfq[r] = make_uint4(0u, 0u, 0u, 0u);
#pragma unroll 1
        for (int w4 = 0; w4 < 4; ++w4) {
            const int qb = (w4 == 0) ? ip : (w4 == 1) ? 255 - ip : (w4 == 2) ? 127 - ip : 128 + ip;
            const int q0 = qb * 16; const size_t tok0 = (size_t)b * S_ + q0;
            {
                const int tid = fresh_tid();
                unsigned char* dst0 = lds + (tid >> 7) * 2064 + (tid & 127) * 16;
                if (w4 == 0) { const unsigned char* src0 = (const unsigned char*)(qi + tok0 * 1024) + (tid >> 7) * 2048 + (tid & 127) * 16;
#pragma unroll
                    for (int r = 0; r < 4; ++r) pfq[r] = *(const uint4*)(src0 + r * 4 * 2048);
                    pfw = tid < 256 ? wi[(tok0 + (tid >> 4)) * 16 + (tid & 15)] : 0.f; }
#pragma unroll
                for (int r = 0; r < 4; ++r) *(uint4*)(dst0 + r * 4 * 2064) = pfq[r];
                if (tid < 256) { const int qq = tid >> 4, hh = tid & 15; ((float*)(lds + 33024))[hh * 16 + qq] = pfw; }
            }
            __syncthreads();
            const int tid = fresh_tid(), wv = tid >> 6, lane = tid & 63, qq = lane & 15, grp = lane >> 4;
            const int qpos = q0 + qq;
            unsigned key[128];
            {
                const unsigned char* qrow = lds + qq * 2064 + grp * 16; const float* wl = (const float*)(lds + 33024) + qq;
                const unsigned char* kbase = (const unsigned char*)(ki + ((size_t)b * S_ + qq) * 64) + grp * 16;
#define IDX_LDQ(q0_, q1_, w_, h_) do { (q0_) = *(const bf16x8*)(qrow + (h_) * 128); (q1_) = *(const bf16x8*)(qrow + (h_) * 128 + 64); (w_) = wl[(h_) * 16]; } while (0)
#define IDX_MM(X_, q0_, q1_) do { _Pragma("unroll") for (int i = 0; i < 2; ++i) (X_)[i] = MFMA16(kf[i][0], (q0_), ((f32x4v){0.f, 0.f, 0.f, 0.f})); \
                                  _Pragma("unroll") for (int i = 0; i < 2; ++i) (X_)[i] = MFMA16(kf[i][1], (q1_), (X_)[i]); } while (0)
#define IDX_ACC(X_, w_) do { _Pragma("unroll") for (int i = 0; i < 2; ++i) _Pragma("unroll") for (int j = 0; j < 4; ++j) sacc[i][j] += (w_) * relu1((X_)[i][j]); } while (0)
#define IDX_LOADKF(dst_, tp_) do { const int kt0_ = wv + 16 * (tp_); _Pragma("unroll") for (int i = 0; i < 2; ++i) { const int kti = kt0_ + 8 * i, ktc = kti <= qb ? kti : kt0_; \
                    (dst_)[i][0] = *(const bf16x8*)(kbase + (size_t)ktc * 2048); (dst_)[i][1] = *(const bf16x8*)(kbase + (size_t)ktc * 2048 + 64); } } while (0)
                bf16x8 kf[2][2], kfn[2][2];
#pragma unroll
                for (int i = 0; i < 2; ++i) { kf[i][0] = (bf16x8){0, 0, 0, 0, 0, 0, 0, 0}; kf[i][1] = kf[i][0]; kfn[i][0] = kf[i][0]; kfn[i][1] = kf[i][0]; }
                if (wv <= qb) IDX_LOADKF(kf, 0);
#pragma unroll
                for (int tp = 0; tp < 16; ++tp) {
                    const int kt0 = wv + 16 * tp;
                    if (tp + 1 < 16 && kt0 + 16 <= qb) IDX_LOADKF(kfn, tp + 1);
                    if (kt0 <= qb) {
                        f32x4v sacc[2];
#pragma unroll
                        for (int i = 0; i < 2; ++i) sacc[i] = (f32x4v){0.f, 0.f, 0.f, 0.f};
                        {
                        f32x4v accA[2], accB[2]; bf16x8 qx0, qx1, qy0, qy1; float wA, wB, wx, wy;
                        IDX_LDQ(qy0, qy1, wA, 0); IDX_LDQ(qx0, qx1, wx, 1);
                        IDX_MM(accA, qy0, qy1);
#pragma unroll 1
                        for (int hh = 0; hh < 7; ++hh) {
                            IDX_LDQ(qy0, qy1, wy, 2 * hh + 2);
                            __builtin_amdgcn_sched_barrier(0);
                            IDX_MM(accB, qx0, qx1); wB = wx;
                            IDX_ACC(accA, wA);
                            __builtin_amdgcn_sched_barrier(0);
                            IDX_LDQ(qx0, qx1, wx, 2 * hh + 3);
                            __builtin_amdgcn_sched_barrier(0);
                            IDX_MM(accA, qy0, qy1); wA = wy;
                            IDX_ACC(accB, wB);
                            __builtin_amdgcn_sched_barrier(0);
                        }
                        IDX_MM(accB, qx0, qx1);
                        IDX_ACC(accA, wA);
                        IDX_ACC(accB, wx);
                        }
#pragma unroll
                        for (int i = 0; i < 2; ++i)
#pragma unroll
                            for (int j = 0; j < 4; ++j) { const int kp = 16 * (kt0 + 8 * i) + 4 * grp + j;
                                key[8 * tp + 4 * i + j] = (kt0 + 8 * i <= qb && kp <= qpos) ? f2key(sacc[i][j]) : 0u; }
                    } else {
#pragma unroll
                        for (int j = 0; j < 8; ++j) key[8 * tp + j] = 0u;
                    }
#pragma unroll
                    for (int i = 0; i < 2; ++i) { kf[i][0] = kfn[i][0]; kf[i][1] = kfn[i][1]; }
                }
#undef IDX_LOADKF
#undef IDX_LDQ
#undef IDX_MM
#undef IDX_ACC
            }
            if (w4 < 3) {
                const int qbn = (w4 == 0) ? 255 - ip : (w4 == 1) ? 127 - ip : 128 + ip; const size_t tokn = (size_t)b * S_ + qbn * 16;
                const unsigned char* srcn = (const unsigned char*)(qi + tokn * 1024) + (tid >> 7) * 2048 + (tid & 127) * 16;
#pragma unroll
                for (int r = 0; r < 4; ++r) pfq[r] = *(const uint4*)(srcn + r * 4 * 2048);
                pfw = tid < 256 ? wi[(tokn + (tid >> 4)) * 16 + (tid & 15)] : 0.f; }
            {
                unsigned* cb = (unsigned*)(lds + 34048);
                unsigned kmax = 0u, kmin1 = 0xFFFFFFFFu;
#pragma unroll
                for (int r = 0; r < 128; ++r) { kmax = key[r] > kmax ? key[r] : kmax; const unsigned k1 = key[r] - 1u; kmin1 = k1 < kmin1 ? k1 : kmin1; }
                { unsigned a = __shfl_xor(kmax, 16); kmax = a > kmax ? a : kmax; a = __shfl_xor(kmax, 32); kmax = a > kmax ? a : kmax;
                  unsigned c = __shfl_xor(kmin1, 16); kmin1 = c < kmin1 ? c : kmin1; c = __shfl_xor(kmin1, 32); kmin1 = c < kmin1 ? c : kmin1; }
                if (lane < 16) { cb[256 + wv * 16 + lane] = kmax; cb[384 + wv * 16 + lane] = kmin1; }
                __syncthreads();
#pragma unroll
                for (int w = 0; w < 8; ++w) { const unsigned a = cb[256 + w * 16 + qq], c = cb[384 + w * 16 + qq]; kmax = a > kmax ? a : kmax; kmin1 = c < kmin1 ? c : kmin1; }
                unsigned lo = kmin1, hi = kmax; bool done = false; int it = 0, side = 0;
                unsigned cntlo = (unsigned)(qpos + 1), cnthi = 0u;
                const float rn = __builtin_amdgcn_rcpf((float)(qpos + 1)), zt = zscore_of_count(256.0f, rn);
                float glo = zt - zscore_of_count((float)(qpos + 1) - 0.5f, rn), ghi = zt - zscore_of_count(0.5f, rn);
                if (qpos < 256) { hi = 0u; done = true; }
                while (!__all(done)) {
                    unsigned mid = lo + ((hi - lo) >> 1);
                    { const float flo = key2f(lo), fhi = key2f(hi); const unsigned dd = cntlo - cnthi;
                      const float fr = dd <= 200u ? (float)(cntlo - 256u) * __builtin_amdgcn_rcpf((float)dd) : glo / (glo - ghi);
                      const float xf = flo + (fhi - flo) * fr;
                      const unsigned kx = f2key(xf); if (kx > lo && kx < hi && (it & 15) != 15) mid = kx; }
                    unsigned c = 0u;
#pragma unroll
                    for (int r = 0; r < 128; ++r) c += (key[r] > mid) ? 1u : 0u;
                    c += __shfl_xor(c, 16); c += __shfl_xor(c, 32);
                    unsigned* cbi = cb + (it & 1) * 128;
                    if (lane < 16) cbi[wv * 16 + lane] = c;
                    __syncthreads();
                    unsigned tot = 0u;
#pragma unroll
                    for (int w = 0; w < 8; ++w) tot += cbi[w * 16 + qq];
                    if (!done) { const float g = zt - zscore_of_count(tot > 0u ? (float)tot : 0.5f, rn);
                        if (tot > 256u) { lo = mid; glo = g; cntlo = tot; if (side == 1) ghi *= 0.5f; side = 1; }
                        else { hi = mid; ghi = g; cnthi = tot; if (side == 2) glo *= 0.5f; side = 2; if (tot == 256u) done = true; }
                        if (hi - lo <= 1u) done = true; }
                    ++it;
                }
                unsigned short* mrow = (unsigned short*)(mask + (tok0 + qq) * 128);
#pragma unroll
                for (int t = 0; t < 32; ++t) { unsigned v = 0u;
#pragma unroll
                    for (int j = 0; j < 4; ++j) v |= (key[4 * t + j] > hi) ? (1u << j) : 0u;
                    v <<= 4 * grp; v |= __shfl_xor(v, 16); v |= __shfl_xor(v, 32);
                    if (lane < 16) mrow[wv + 8 * t] = (unsigned short)v; }
            }
            __syncthreads();
        }
    }
}
template <int DQK, bool MASKED>
__device__ __forceinline__ void attn_qblock(unsigned char* lds, const bf16_t* Qh, int ldq, const bf16_t* Kh, int ldk, const bf16_t* Kpe, const bf16_t* Vth, const unsigned* mask, bf16_t* outh, int b, int q0) {
    constexpr int NKK = DQK / 16, PPR = DQK / 8, NPK = 64 * PPR / 512, KSTR = DQK * 2 + 16, VSTR = 136, KBUF = 64 * KSTR, VBUF = 128 * VSTR, VOFF = 2 * KBUF;
    const int tid = fresh_tid(), wv = tid >> 6, lane = tid & 63, ql = lane & 31, half = lane >> 5;
    const int qpos = q0 + 32 * wv + ql; const size_t tq = (size_t)b * S_ + qpos;
    const bool late = wv >= 4;
    bf16x8 qf[NKK];
#pragma unroll
    for (int kk = 0; kk < NKK; ++kk) qf[kk] = *(const bf16x8*)(Qh + tq * ldq + 16 * kk + 8 * half);
    f32x16 o[4];
#pragma unroll
    for (int dt = 0; dt < 4; ++dt)
#pragma unroll
        for (int e = 0; e < 16; ++e) o[dt][e] = 0.f;
    float m = -1e30f, l = 0.f;
    const int ntiles = (q0 + 256) / 64;
    bf16x8 pb0, pb1, pb2, pb3;
#pragma unroll
    for (int j = 0; j < 8; ++j) { pb0[j] = 0; pb1[j] = 0; pb2[j] = 0; pb3[j] = 0; }
    uint4 kreg0, kreg1, kreg2, vreg0, vreg1; kreg2.x = kreg2.y = kreg2.z = kreg2.w = 0u;
#define ATT_KSRC(r_, it_) ({ const int pp_ = tid + 512 * (r_), row_ = pp_ / PPR, pc_ = pp_ % PPR; const size_t tok_ = (size_t)b * S_ + (it_) * 64 + row_; \
        (const uint4*)((pc_ < 16) ? Kh + tok_ * ldk + 8 * pc_ : Kpe + tok_ * 64 + 8 * (pc_ - 16)); })
#define ATT_VSRC(r_, it_) ({ const int pp_ = tid + 512 * (r_), row_ = pp_ >> 3, pc_ = pp_ & 7; (const uint4*)(Vth + (size_t)row_ * T_ + (size_t)b * S_ + (it_) * 64 + 8 * pc_); })
#define ATT_LOADG(it_) do { kreg0 = *ATT_KSRC(0, it_); kreg1 = *ATT_KSRC(1, it_); if (NPK == 3) kreg2 = *ATT_KSRC(2, it_); vreg0 = *ATT_VSRC(0, it_); vreg1 = *ATT_VSRC(1, it_); } while (0)
#define ATT_KDST(r_, base_) ({ const int pp_ = tid + 512 * (r_), row_ = pp_ / PPR, pc_ = pp_ % PPR; (uint4*)((base_) + row_ * KSTR + pc_ * 16); })
#define ATT_VST(r_, base_, v_) do { const int pp_ = tid + 512 * (r_), row_ = pp_ >> 3, pc_ = pp_ & 7; uint2 a_, b_; a_.x = (v_).x; a_.y = (v_).y; b_.x = (v_).z; b_.y = (v_).w; \
        *(uint2*)((base_) + row_ * VSTR + pc_ * 16) = a_; *(uint2*)((base_) + row_ * VSTR + pc_ * 16 + 8) = b_; } while (0)
#define ATT_STOREL(kb_, vb_) do { unsigned char* kbase_ = lds + (kb_) * KBUF; unsigned char* vbase_ = lds + VOFF + (vb_) * VBUF; *ATT_KDST(0, kbase_) = kreg0; *ATT_KDST(1, kbase_) = kreg1; if (NPK == 3) *ATT_KDST(2, kbase_) = kreg2; \
        ATT_VST(0, vbase_, vreg0); ATT_VST(1, vbase_, vreg1); } while (0)
#define ATT_QKSM(kb_, it_) do { const unsigned char* kb = lds + (kb_) * KBUF; const int s0 = (it_) * 64; \
        f32x16 st0, st1; \
        _Pragma("unroll") for (int e = 0; e < 16; ++e) { st0[e] = 0.f; st1[e] = 0.f; } \
        { const unsigned char* kp0 = kb + ql * KSTR + 16 * half; const unsigned char* kp1 = kp0 + 32 * KSTR; bf16x8 ka[2][4]; \
          ka[0][0] = *(const bf16x8*)(kp0); ka[0][1] = *(const bf16x8*)(kp1); ka[0][2] = *(const bf16x8*)(kp0 + 32); ka[0][3] = *(const bf16x8*)(kp1 + 32); \
          __builtin_amdgcn_sched_barrier(0); \
          _Pragma("unroll") for (int c = 0; c < NKK / 2; ++c) { \
            if (c + 1 < NKK / 2) { ka[(c + 1) & 1][0] = *(const bf16x8*)(kp0 + 64 * (c + 1)); ka[(c + 1) & 1][1] = *(const bf16x8*)(kp1 + 64 * (c + 1)); \
                                   ka[(c + 1) & 1][2] = *(const bf16x8*)(kp0 + 64 * (c + 1) + 32); ka[(c + 1) & 1][3] = *(const bf16x8*)(kp1 + 64 * (c + 1) + 32); } \
            __builtin_amdgcn_sched_barrier(0); \
            st0 = MFMA32(ka[c & 1][0], qf[2 * c], st0); st1 = MFMA32(ka[c & 1][1], qf[2 * c], st1); st0 = MFMA32(ka[c & 1][2], qf[2 * c + 1], st0); st1 = MFMA32(ka[c & 1][3], qf[2 * c + 1], st1); \
            __builtin_amdgcn_sched_barrier(0); } } \
        if (MASKED) { const uint2 mw = mwcur; const unsigned w0 = mw.x >> (4 * half), w1 = mw.y >> (4 * half); \
            _Pragma("unroll") for (int e = 0; e < 16; ++e) { const int bit = (e & 3) + 8 * (e >> 2); st0[e] = ((w0 >> bit) & 1u) ? st0[e] : -INFINITY; st1[e] = ((w1 >> bit) & 1u) ? st1[e] : -INFINITY; } \
        } else if (s0 + 63 > q0 + 32 * wv) { \
            _Pragma("unroll") for (int e = 0; e < 16; ++e) { const int key0 = s0 + (e & 3) + 8 * (e >> 2) + 4 * half; if (key0 > qpos) st0[e] = -INFINITY; if (key0 + 32 > qpos) st1[e] = -INFINITY; } \
        } \
        float mx = fmaxf(st0[0], st1[0]); \
        _Pragma("unroll") for (int e = 1; e < 16; ++e) mx = fmaxf(mx, fmaxf(st0[e], st1[e])); \
        mx = fmaxf(mx, __shfl_xor(mx, 32)); \
          \
        const bool keep = __all(mx - m <= 8.0f); float alpha = 1.0f; \
        if (!keep) { const float mnew = fmaxf(m, mx); alpha = __builtin_amdgcn_exp2f(m - mnew); m = mnew; } \
        float ps = 0.f; \
        _Pragma("unroll") for (int e = 0; e < 16; ++e) { st0[e] = __builtin_amdgcn_exp2f(st0[e] - m); st1[e] = __builtin_amdgcn_exp2f(st1[e] - m); ps += st0[e] + st1[e]; } \
        l = l * alpha + ps; \
        if (!keep) { \
            _Pragma("unroll") for (int dt = 0; dt < 4; ++dt) \
                _Pragma("unroll") for (int e = 0; e < 16; ++e) o[dt][e] *= alpha; } \
        { u32x4_t pw; \
          pw.x = pk2(st0[0], st0[1]); pw.y = pk2(st0[2], st0[3]); pw.z = pk2(st0[4], st0[5]); pw.w = pk2(st0[6], st0[7]); pb0 = __builtin_bit_cast(bf16x8, pw); \
          pw.x = pk2(st0[8], st0[9]); pw.y = pk2(st0[10], st0[11]); pw.z = pk2(st0[12], st0[13]); pw.w = pk2(st0[14], st0[15]); pb1 = __builtin_bit_cast(bf16x8, pw); \
          pw.x = pk2(st1[0], st1[1]); pw.y = pk2(st1[2], st1[3]); pw.z = pk2(st1[4], st1[5]); pw.w = pk2(st1[6], st1[7]); pb2 = __builtin_bit_cast(bf16x8, pw); \
          pw.x = pk2(st1[8], st1[9]); pw.y = pk2(st1[10], st1[11]); pw.z = pk2(st1[12], st1[13]); pw.w = pk2(st1[14], st1[15]); pb3 = __builtin_bit_cast(bf16x8, pw); } \
    } while (0)
#define ATT_LDV(dst_, vbp_, g_) do { _Pragma("unroll") for (int dt = 0; dt < 4; ++dt) { const unsigned char* vp = (vbp_) + (32 * dt + ql) * VSTR + (16 * (g_) + 4 * half) * 2; \
            const s16x4 lo = *(const s16x4*)vp, hi = *(const s16x4*)(vp + 16); (dst_)[dt] = __builtin_shufflevector(lo, hi, 0, 1, 2, 3, 4, 5, 6, 7); } } while (0)
#define ATT_MMV(src_, pb_) do { _Pragma("unroll") for (int dt = 0; dt < 4; ++dt) o[dt] = MFMA32((src_)[dt], (pb_), o[dt]); } while (0)
#define ATT_PV(vb_) do { const unsigned char* vbp = lds + VOFF + (vb_) * VBUF; bf16x8 va[2][4]; \
        ATT_LDV(va[0], vbp, 0); __builtin_amdgcn_sched_barrier(0); \
        ATT_LDV(va[1], vbp, 1); __builtin_amdgcn_sched_barrier(0); ATT_MMV(va[0], pb0); __builtin_amdgcn_sched_barrier(0); \
        ATT_LDV(va[0], vbp, 2); __builtin_amdgcn_sched_barrier(0); ATT_MMV(va[1], pb1); __builtin_amdgcn_sched_barrier(0); \
        ATT_LDV(va[1], vbp, 3); __builtin_amdgcn_sched_barrier(0); ATT_MMV(va[0], pb2); __builtin_amdgcn_sched_barrier(0); \
        ATT_MMV(va[1], pb3); __builtin_amdgcn_sched_barrier(0); } while (0)
    ATT_LOADG(0); ATT_STOREL(0, 0); if (ntiles > 1) ATT_LOADG(1);
    uint2 mwcur = make_uint2(0u, 0u), mwnext = make_uint2(0u, 0u);
    if (MASKED) mwcur = *(const uint2*)(mask + tq * 128);
    const int qmaxw = q0 + 32 * wv + 31;
    int vcur = 0, vprev = 2;
    for (int it = 0; it < ntiles; ++it) {
        const int vnext = vcur == 2 ? 0 : vcur + 1;
        __syncthreads();
        if (it + 1 < ntiles) { ATT_STOREL((it + 1) & 1, vnext); if (it + 2 < ntiles) ATT_LOADG(it + 2); }
        if (MASKED && it + 1 < ntiles) mwnext = *(const uint2*)(mask + tq * 128 + 2 * (it + 1));
        const bool vis = it * 64 <= qmaxw;
        if (!late) { if (vis) { ATT_QKSM(it & 1, it); ATT_PV(vcur); } }
        else { if (it > 0 && (it - 1) * 64 <= qmaxw) ATT_PV(vprev); if (vis) ATT_QKSM(it & 1, it); }
        vprev = vcur; vcur = vnext; mwcur = mwnext;
    }
    if (late && (ntiles - 1) * 64 <= qmaxw) ATT_PV(vprev);
    __syncthreads();
#undef ATT_LOADG
#undef ATT_STOREL
#undef ATT_KSRC
#undef ATT_VSRC
#undef ATT_KDST
#undef ATT_VST
#undef ATT_QKSM
#undef ATT_LDV
#undef ATT_MMV
#undef ATT_PV
    l += __shfl_xor(l, 32); const float inv = 1.0f / l;
#pragma unroll
    for (int dt = 0; dt < 4; ++dt)
#pragma unroll
        for (int g = 0; g < 4; ++g) { uint2 w; w.x = pk2(o[dt][4 * g] * inv, o[dt][4 * g + 1] * inv); w.y = pk2(o[dt][4 * g + 2] * inv, o[dt][4 * g + 3] * inv);
            *(uint2*)(outh + tq * 2048 + 32 * dt + 8 * g + 4 * half) = w; }
}
__device__ __forceinline__ void attn_job(unsigned char* lds, unsigned char* ws) {
    const bf16_t *qa = (const bf16_t*)(ws + OFF_QA), *ka = (const bf16_t*)(ws + OFF_KA), *vta = (const bf16_t*)(ws + OFF_VTA), *qm = (const bf16_t*)(ws + OFF_QM), *kn = (const bf16_t*)(ws + OFF_KNOPE),
                 *kr = (const bf16_t*)(ws + OFF_KR), *vtb = (const bf16_t*)(ws + OFF_VTB); const unsigned* mask = (const unsigned*)(ws + OFF_MASK); bf16_t* ao = (bf16_t*)(ws + OFF_AO);
    for (int u = blockIdx.x; u < 512; u += gridDim.x) {
        const int type = u >> 8, r0 = u & 255, r = (r0 & 7) * 32 + (r0 >> 3), bh = r >> 3, pair = r & 7, b = bh >> 3, h = bh & 7;
        if (type == 0) { for (int w2 = 0; w2 < 2; ++w2) attn_qblock<128, true>(lds, qa + h * 128, 1024, ka + h * 128, 1024, ka, vta + (size_t)h * 128 * T_, mask, ao + h * 128, b, (w2 ? pair : 15 - pair) * 256); }
        else { for (int w2 = 0; w2 < 2; ++w2) attn_qblock<192, false>(lds, qm + h * 192, 1536, kn + h * 128, 1024, kr, vtb + (size_t)h * 128 * T_, mask, ao + 1024 + h * 128, b, (w2 ? pair : 15 - pair) * 256); }
    }
}
#define XB_XCNT(j) (64 * (j))
#define XB_XSUB(j) (1024 + 64 * (j))
#define XB_XGEN(j) (2048 + 64 * (j))
#define XB_TOP 3072
#define XB_TOPGEN 3136
__device__ __forceinline__ unsigned xb_ld(unsigned* p) { return __hip_atomic_load(p, __ATOMIC_RELAXED, __HIP_MEMORY_SCOPE_AGENT); }
__device__ __forceinline__ unsigned xb_add(unsigned* p, unsigned v) { return __hip_atomic_fetch_add(p, v, __ATOMIC_RELAXED, __HIP_MEMORY_SCOPE_AGENT); }
__device__ __forceinline__ unsigned xb_xcc_id() { return (unsigned)__builtin_amdgcn_s_getreg((3 << 11) | 20) & 0xFu; }
__device__ __forceinline__ void grid_bar(unsigned* bar, unsigned x, unsigned nloc, unsigned nx, unsigned k) {
    asm volatile("s_waitcnt vmcnt(0)" ::: "memory");
    __syncthreads();
    if (threadIdx.x == 0) {
        const unsigned old = xb_add(&bar[XB_XSUB(x)], 1u);
        if (old + 1u == k * nloc) {
            __builtin_amdgcn_fence(__ATOMIC_RELEASE, "agent");
            asm volatile("s_waitcnt vmcnt(0)" ::: "memory");
            const unsigned og = xb_add(&bar[XB_TOP], 1u);
            if (og + 1u == k * nx) xb_add(&bar[XB_TOPGEN], 1u);
            else while (xb_ld(&bar[XB_TOPGEN]) < k) __builtin_amdgcn_s_sleep(1);
            __builtin_amdgcn_fence(__ATOMIC_ACQUIRE, "agent");
            xb_add(&bar[XB_XGEN(x)], 1u);
            asm volatile("s_waitcnt vmcnt(0)" ::: "memory");
        } else {
            while (xb_ld(&bar[XB_XGEN(x)]) < k) __builtin_amdgcn_s_sleep(1);
            __builtin_amdgcn_fence(__ATOMIC_ACQUIRE, "agent");
            asm volatile("s_waitcnt vmcnt(0)" ::: "memory");
        }
    }
    __syncthreads();
}
#ifndef GEMM_SEL
#define GEMM_SEL 127
#endif
#ifndef GEMM_ALIGN
#define GEMM_ALIGN true
#endif
#ifndef GEMM_SP2
#define GEMM_SP2 true
#endif
extern __shared__ __attribute__((aligned(16))) unsigned char dyn_lds[];
template <class Epi> __device__ __forceinline__ void run_gemm(const bf16_t* A, const bf16_t* Bt, int M, int N, int K, const Epi& E) {
    asm volatile("" : "+s"(M), "+s"(N), "+s"(K));
    pg8::Gemm g; g.A = A; g.Bt = Bt; g.M = M; g.N = N; g.K = K;
    pg8::StaticOrder S; S.init(M, N, (int)gridDim.x, (int)blockIdx.x);
#ifndef NO_GEMM
    if constexpr ((GEMM_SEL & Epi::ID) != 0) pg8::gemm_phase<Epi, pg8::StaticOrder, GEMM_ALIGN, GEMM_SP2>((PG8_LAS unsigned char*)dyn_lds, g, S, E);
#endif
}
__global__ void __launch_bounds__(512) mega(const Params p) {
    cg::grid_group grid = cg::this_grid();
    unsigned char* lds = dyn_lds; unsigned char* ws = p.ws;
    bf16_t* xb = (bf16_t*)(ws + OFF_XB); float* rt = (float*)(ws + OFF_RT);
    unsigned* barw = (unsigned*)(ws + OFF_BAR); const unsigned xcc = xb_xcc_id();
    if (threadIdx.x == 0) (void)xb_add(&barw[XB_XCNT(xcc)], 1u);
#ifndef NO_MISC
    rope_table_job(p.pos, rt);
    x_to_bf16_job(p.x, xb);
    conv_attn_weights(lds, p, 0);
#endif
    grid.sync();
    unsigned nbar = 0u, nloc = 1u, nxcd = 0u;
    for (unsigned j = 0; j < 16; ++j) { const unsigned c = xb_ld(&barw[XB_XCNT(j)]); nxcd += c > 0u ? 1u : 0u; nloc = (j == xcc) ? c : nloc; }
#pragma unroll 1
    for (int l = 0; l < 2; ++l) {
        {
            pg8::EpiInMain e; e.qa = (bf16_t*)(ws + OFF_QA); e.ka = (bf16_t*)(ws + OFF_KA); e.qi = (bf16_t*)(ws + OFF_QI); e.cq = (bf16_t*)(ws + OFF_CQ); e.ckv = (bf16_t*)(ws + OFF_CKV);
            e.ki = (bf16_t*)(ws + OFF_KI); e.kr = (bf16_t*)(ws + OFF_KR); e.wi = (float*)(ws + OFF_WI); e.rsq = (float*)(ws + OFF_RSQ); e.rskv = (float*)(ws + OFF_RSKV); e.rt = rt;
            run_gemm(xb, (const bf16_t*)(ws + OFF_WIN), T_, 4096, DM_, e);
            pg8::EpiPlainBf16 ev; ev.O = (bf16_t*)(ws + OFF_VTA); ev.ldc = T_;
            run_gemm((const bf16_t*)(ws + OFF_WVA), xb, 1024, T_, DM_, ev);
        }
        grid_bar(barw, xcc, nloc, nxcd, ++nbar);
        {
            pg8::EpiUq eq; eq.O = (bf16_t*)(ws + OFF_QM); eq.rsq = (const float*)(ws + OFF_RSQ); eq.rt = rt;
            run_gemm((const bf16_t*)(ws + OFF_CQ), (const bf16_t*)(ws + OFF_WUQ), T_, 1536, 512, eq);
            pg8::EpiUkvK ek; ek.O = (bf16_t*)(ws + OFF_KNOPE); ek.rskv = (const float*)(ws + OFF_RSKV);
            run_gemm((const bf16_t*)(ws + OFF_CKV), (const bf16_t*)(ws + OFF_WUKK), T_, 1024, 256, ek);
            pg8::EpiUkvV ev; ev.O = (bf16_t*)(ws + OFF_VTB); ev.rskv = (const float*)(ws + OFF_RSKV);
            run_gemm((const bf16_t*)(ws + OFF_WUKV), (const bf16_t*)(ws + OFF_CKV), 1024, T_, 256, ev);
#ifndef NO_IDX
            indexer_job(lds, (const bf16_t*)(ws + OFF_QI), (const bf16_t*)(ws + OFF_KI), (const float*)(ws + OFF_WI), (unsigned*)(ws + OFF_MASK));
#endif
        }
        grid_bar(barw, xcc, nloc, nxcd, ++nbar);
#ifndef NO_ATTN
        attn_job(lds, ws);
#endif
        grid_bar(barw, xcc, nloc, nxcd, ++nbar);
        {
            pg8::EpiResB e; e.Y = (bf16_t*)(ws + OFF_QA); e.X = xb;
            run_gemm((const bf16_t*)(ws + OFF_AO), (const bf16_t*)(ws + OFF_WO), T_, DM_, DM_, e);
        }
        grid_bar(barw, xcc, nloc, nxcd, ++nbar);
#ifndef NO_MISC
        conv_ffn_weights(lds, p, l);
        ln_job((const bf16_t*)(ws + OFF_QA), p.ln1_g + l * DM_, p.ln1_b + l * DM_, xb, nullptr);
#endif
        grid_bar(barw, xcc, nloc, nxcd, ++nbar);
        {
            pg8::EpiGU e; e.O = (bf16_t*)(ws + OFF_QA);
            run_gemm(xb, (const bf16_t*)(ws + OFF_WGU), T_, 2 * FF_, DM_, e);
        }
        grid_bar(barw, xcc, nloc, nxcd, ++nbar);
        {
            pg8::EpiResB e; e.Y = (bf16_t*)(ws + OFF_AO); e.X = xb;
            run_gemm((const bf16_t*)(ws + OFF_QA), (const bf16_t*)(ws + OFF_WDN), T_, DM_, FF_, e);
        }
        grid_bar(barw, xcc, nloc, nxcd, ++nbar);
#ifndef NO_MISC
        if (l + 1 < 2) conv_attn_weights(lds, p, l + 1);
        ln_job((const bf16_t*)(ws + OFF_AO), p.ln2_g + l * DM_, p.ln2_b + l * DM_, l + 1 < 2 ? xb : nullptr, l + 1 < 2 ? nullptr : p.out);
#endif
        grid_bar(barw, xcc, nloc, nxcd, ++nbar);
    }
}

extern "C" void kernel_launch(void* const* d_in, const int* in_sizes, int n_in, void* d_out, int out_size, void* d_ws, size_t ws_size, hipStream_t stream) {
    constexpr size_t kDynLds = 131072;
    static int grid_blocks = 0;
    if (!grid_blocks) {
        int dev = 0, cus = 0, per_cu = 0;
        (void)hipGetDevice(&dev);
        (void)hipDeviceGetAttribute(&cus, hipDeviceAttributeMultiprocessorCount, dev);
        (void)hipFuncSetAttribute((const void*)mega, hipFuncAttributeMaxDynamicSharedMemorySize, (int)kDynLds);
        (void)hipOccupancyMaxActiveBlocksPerMultiprocessor(&per_cu, mega, 512, kDynLds);
        if (per_cu < 1) per_cu = 1;
        grid_blocks = cus;
    }
    (void)hipMemsetAsync((unsigned char*)d_ws + OFF_BAR, 0, 16384, stream);
    Params p{};
    p.x = (const float*)d_in[0]; p.pos = (const int*)d_in[1]; p.w_in = (const float*)d_in[2]; p.g_cq = (const float*)d_in[3]; p.g_ckv = (const float*)d_in[4];
    p.w_uq = (const float*)d_in[5]; p.w_ukv = (const float*)d_in[6]; p.w_o = (const float*)d_in[7]; p.ln1_g = (const float*)d_in[8]; p.ln1_b = (const float*)d_in[9];
    p.w_gate = (const float*)d_in[10]; p.w_up = (const float*)d_in[11]; p.w_down = (const float*)d_in[12]; p.ln2_g = (const float*)d_in[13]; p.ln2_b = (const float*)d_in[14];
    p.out = (float*)d_out; p.ws = (unsigned char*)d_ws;
    void* args[] = {&p};
    hipError_t e = hipLaunchCooperativeKernel((void*)mega, dim3(grid_blocks), dim3(512), args, kDynLds, stream);
    if (e != hipSuccess) fprintf(stderr, "cooperative launch failed: %s (grid %d)\n", hipGetErrorString(e), grid_blocks);
}
```
